# Optimizing an MI355X kernel written in HIP

```python
import math
import jax, jax.numpy as jnp
from jax import lax
import numpy as np

D_MODEL = 2048
BATCH = 8
SEQ = 2048
DEPTH = 4

N_MIXERS = 3
BLK = 128
EPS = 1e-6
HEAD_DIM = 64
D_FF = 4 * D_MODEL

SWA_HEADS = D_MODEL // HEAD_DIM
SWA_KV = SWA_HEADS // 8
SWA_WINDOW = 128
SWA_IN = (SWA_HEADS + 2 * SWA_KV) * HEAD_DIM

DSA_HD = 128
DSA_HEADS = D_MODEL // DSA_HD
DSA_QRANK = D_MODEL // 4
DSA_KVRANK = D_MODEL // 8
IDX_HEADS = 16
IDX_DIM = 64
TOPK_MAX = 256
DSA_IN = DSA_QRANK + DSA_KVRANK + IDX_DIM + IDX_HEADS

DIL_PATTERNS = ((128, 1), (512, 4), (2048, 16))
DIL_GROUPS = len(DIL_PATTERNS)
DIL_HEADS = D_MODEL // 128
DIL_KV = DIL_HEADS // 4
DIL_GROUP_COLS = (DIL_HEADS + 2 * DIL_KV) * HEAD_DIM
DIL_IN = DIL_GROUPS * DIL_GROUP_COLS
DIL_PAD = max(w for w, _ in DIL_PATTERNS)

N_SWA = (DEPTH + 2) // 3
N_DSA = (DEPTH + 1) // 3
N_DIL = DEPTH // 3

kernel_name = "hybrid_swa_dsa_dilated_adaln_trunk"


def rms_norm(x, g):
    xf = x.astype(jnp.float32)
    y = xf * lax.rsqrt(jnp.mean(xf * xf, axis=-1, keepdims=True) + EPS)
    return (y * g.astype(jnp.float32)).astype(x.dtype)


def alibi_slopes(n):
    return 2.0 ** (-8.0 * jnp.arange(1, n + 1, dtype=jnp.float32) / n)


def sweep_blocks(fn, seq_len):
    out = lax.map(fn, jnp.arange(seq_len // BLK, dtype=jnp.int32) * BLK)
    out = jnp.moveaxis(out, 0, 1)
    return out.reshape(out.shape[0], seq_len, *out.shape[3:])


def mixer_swa(h, w_in, qn_g, kn_g, sinks, w_out):
    B, S, _ = h.shape
    G = SWA_HEADS // SWA_KV
    q, k, v = jnp.split(h @ w_in, [SWA_HEADS * HEAD_DIM, (SWA_HEADS + SWA_KV) * HEAD_DIM], axis=-1)
    q = rms_norm(q.reshape(B, S, SWA_KV, G, HEAD_DIM), qn_g)
    k = rms_norm(k.reshape(B, S, SWA_KV, HEAD_DIM), kn_g)
    v = v.reshape(B, S, SWA_KV, HEAD_DIM)
    pad = ((0, 0), (SWA_WINDOW, 0), (0, 0), (0, 0))
    k_pad, v_pad = jnp.pad(k, pad), jnp.pad(v, pad)
    slopes = alibi_slopes(SWA_HEADS).reshape(SWA_KV, G)
    sink = sinks.astype(jnp.float32).reshape(SWA_KV, G)
    span = BLK + SWA_WINDOW
    scale = HEAD_DIM ** -0.5

    def block(t0):
        qb = lax.dynamic_slice_in_dim(q, t0, BLK, 1)
        kb = lax.dynamic_slice_in_dim(k_pad, t0, span, 1)
        vb = lax.dynamic_slice_in_dim(v_pad, t0, span, 1)
        t = t0 + jnp.arange(BLK)
        s = t0 - SWA_WINDOW + jnp.arange(span)
        dist = t[:, None] - s[None, :]
        valid = (dist >= 0) & (dist < SWA_WINDOW) & (s[None, :] >= 0)
        logits = (jnp.einsum('bqkgd,bskd->bkgqs', qb, kb).astype(jnp.float32) * scale
                  - slopes[:, :, None, None] * dist.astype(jnp.float32))
        logits = jnp.where(valid, logits, -jnp.inf)
        sink_col = jnp.broadcast_to(sink[None, :, :, None, None], logits.shape[:-1] + (1,))
        p = jax.nn.softmax(jnp.concatenate([sink_col, logits], axis=-1), axis=-1)[..., 1:]
        return jnp.einsum('bkgqs,bskd->bqkgd', p.astype(vb.dtype), vb)

    o = sweep_blocks(block, S)
    return o.reshape(B, S, -1) @ w_out


def mixer_dsa(h, w_in, qlat_g, kvlat_g, w_uq, w_ukv, w_idx_q, qn_g, kn_g, w_out):
    B, S, _ = h.shape
    topk = min(TOPK_MAX, S // 4)
    q_lat, kv_lat, k_idx, w_idx = jnp.split(
        h @ w_in, [DSA_QRANK, DSA_QRANK + DSA_KVRANK, DSA_QRANK + DSA_KVRANK + IDX_DIM], axis=-1)
    q_lat = rms_norm(q_lat, qlat_g)
    kv_lat = rms_norm(kv_lat, kvlat_g)
    q = rms_norm((q_lat @ w_uq).reshape(B, S, DSA_HEADS, DSA_HD), qn_g)
    k, v = jnp.split(kv_lat @ w_ukv, 2, axis=-1)
    k = rms_norm(k, kn_g)
    q_idx = (q_lat @ w_idx_q).reshape(B, S, IDX_HEADS, IDX_DIM)
    w_idx = w_idx.astype(jnp.float32) * (IDX_HEADS ** -0.5)
    slopes = alibi_slopes(DSA_HEADS)
    scale = DSA_HD ** -0.5
    s_all = jnp.arange(S)

    def block(t0):
        t = t0 + jnp.arange(BLK)
        qi = lax.dynamic_slice_in_dim(q_idx, t0, BLK, 1)
        wi = lax.dynamic_slice_in_dim(w_idx, t0, BLK, 1)
        rel = jax.nn.relu(jnp.einsum('bqhd,bsd->bqhs', qi, k_idx).astype(jnp.float32) * IDX_DIM ** -0.5)
        score = jnp.einsum('bqh,bqhs->bqs', wi, rel)
        score = jnp.where(s_all[None, None, :] <= t[None, :, None], score, -jnp.inf)
        _, idx = lax.top_k(score, topk)
        valid = idx <= t[None, :, None]
        k_sel = jax.vmap(lambda kb, ib: kb[ib])(k, idx)
        v_sel = jax.vmap(lambda vb, ib: vb[ib])(v, idx)
        qb = lax.dynamic_slice_in_dim(q, t0, BLK, 1)
        dist = (t[None, :, None] - idx).astype(jnp.float32)
        logits = (jnp.einsum('bqhd,bqjd->bhqj', qb, k_sel).astype(jnp.float32) * scale
                  - slopes[None, :, None, None] * dist[:, None])
        logits = jnp.where(valid[:, None], logits, -jnp.inf)
        p = jax.nn.softmax(logits, axis=-1)
        return jnp.einsum('bhqj,bqjd->bqhd', p.astype(v_sel.dtype), v_sel)

    o = sweep_blocks(block, S)
    return o.reshape(B, S, -1) @ w_out


def mixer_dilated(h, w_in, qn_g, kn_g, w_out):
    B, S, _ = h.shape
    G = DIL_HEADS // DIL_KV
    proj = h @ w_in
    pad = ((0, 0), (DIL_PAD, 0), (0, 0), (0, 0))
    groups = []
    for gi in range(DIL_GROUPS):
        part = proj[..., gi * DIL_GROUP_COLS:(gi + 1) * DIL_GROUP_COLS]
        q, k, v = jnp.split(part, [DIL_HEADS * HEAD_DIM, (DIL_HEADS + DIL_KV) * HEAD_DIM], axis=-1)
        q = rms_norm(q.reshape(B, S, DIL_KV, G, HEAD_DIM), qn_g[gi])
        k = rms_norm(k.reshape(B, S, DIL_KV, HEAD_DIM), kn_g[gi])
        v = v.reshape(B, S, DIL_KV, HEAD_DIM)
        groups.append((q, jnp.pad(k, pad), jnp.pad(v, pad)))
    slopes = alibi_slopes(DIL_HEADS).reshape(DIL_KV, G)
    scale = HEAD_DIM ** -0.5

    def block(t0):
        t = t0 + jnp.arange(BLK)
        outs, lses = [], []
        for (win, dil), (q, k_pad, v_pad) in zip(DIL_PATTERNS, groups):
            j = jnp.arange(win // dil + 1)
            src = t[:, None] - j[None, :] * dil
            valid = src >= 0
            kg = jnp.take(k_pad, src + DIL_PAD, axis=1)
            vg = jnp.take(v_pad, src + DIL_PAD, axis=1)
            qb = lax.dynamic_slice_in_dim(q, t0, BLK, 1)
            logits = (jnp.einsum('bqkgd,bqjkd->bkgqj', qb, kg).astype(jnp.float32) * scale
                      - slopes[:, :, None, None] * (j * dil).astype(jnp.float32))
            logits = jnp.where(valid, logits, -jnp.inf)
            lse = jax.nn.logsumexp(logits, axis=-1)
            p = jnp.exp(logits - lse[..., None])
            outs.append(jnp.einsum('bkgqj,bqjkd->bqkgd', p.astype(vg.dtype), vg))
            lses.append(lse)
        wts = jax.nn.softmax(jnp.stack(lses, 0), axis=0)
        wts = jnp.transpose(wts, (0, 1, 4, 2, 3))
        return jnp.einsum('nbqkg,nbqkgd->bqkgd', wts.astype(outs[0].dtype), jnp.stack(outs, 0))

    o = sweep_blocks(block, S)
    return o.reshape(B, S, -1) @ w_out


def squared_relu_mlp(h, w1, w2):
    return jnp.square(jax.nn.relu(h @ w1)) @ w2


def setup_inputs(seed: int = 0) -> dict:
    key = jax.random.key(seed)
    ks = iter(jax.random.split(key, 40))

    def nrm(shape, scale):
        return jax.random.normal(next(ks), shape, jnp.float32) * scale

    def gain(shape):
        return 1.0 + 0.02 * jax.random.normal(next(ks), shape, jnp.float32)

    D = D_MODEL
    return {
        "x": nrm((BATCH, SEQ, D), 1.0),
        "c": nrm((BATCH, D), 1.0),
        "ada_w": nrm((DEPTH, D, 6 * D), D ** -0.5),
        "ada_b": nrm((DEPTH, 6 * D), 0.02),
        "norm1_g": gain((DEPTH, D)),
        "norm2_g": gain((DEPTH, D)),
        "mlp_w1": nrm((DEPTH, D, D_FF), D ** -0.5),
        "mlp_w2": nrm((DEPTH, D_FF, D), D_FF ** -0.5),
        "swa_w_in": nrm((N_SWA, D, SWA_IN), D ** -0.5),
        "swa_qn_g": gain((N_SWA, HEAD_DIM)),
        "swa_kn_g": gain((N_SWA, HEAD_DIM)),
        "swa_sinks": nrm((N_SWA, SWA_HEADS), 1.0),
        "swa_w_out": nrm((N_SWA, SWA_HEADS * HEAD_DIM, D), (SWA_HEADS * HEAD_DIM) ** -0.5),
        "dsa_w_in": nrm((N_DSA, D, DSA_IN), D ** -0.5),
        "dsa_qlat_g": gain((N_DSA, DSA_QRANK)),
        "dsa_kvlat_g": gain((N_DSA, DSA_KVRANK)),
        "dsa_w_uq": nrm((N_DSA, DSA_QRANK, DSA_HEADS * DSA_HD), DSA_QRANK ** -0.5),
        "dsa_w_ukv": nrm((N_DSA, DSA_KVRANK, 2 * DSA_HD), DSA_KVRANK ** -0.5),
        "dsa_w_idx_q": nrm((N_DSA, DSA_QRANK, IDX_HEADS * IDX_DIM), DSA_QRANK ** -0.5),
        "dsa_qn_g": gain((N_DSA, DSA_HD)),
        "dsa_kn_g": gain((N_DSA, DSA_HD)),
        "dsa_w_out": nrm((N_DSA, DSA_HEADS * DSA_HD, D), (DSA_HEADS * DSA_HD) ** -0.5),
        "dil_w_in": nrm((N_DIL, D, DIL_IN), D ** -0.5),
        "dil_qn_g": gain((N_DIL, DIL_GROUPS, HEAD_DIM)),
        "dil_kn_g": gain((N_DIL, DIL_GROUPS, HEAD_DIM)),
        "dil_w_out": nrm((N_DIL, DIL_HEADS * HEAD_DIM, D), (DIL_HEADS * HEAD_DIM) ** -0.5),
    }


def reference(x, c, ada_w, ada_b, norm1_g, norm2_g, mlp_w1, mlp_w2,
              swa_w_in, swa_qn_g, swa_kn_g, swa_sinks, swa_w_out,
              dsa_w_in, dsa_qlat_g, dsa_kvlat_g, dsa_w_uq, dsa_w_ukv, dsa_w_idx_q,
              dsa_qn_g, dsa_kn_g, dsa_w_out,
              dil_w_in, dil_qn_g, dil_kn_g, dil_w_out):
    cond = jax.nn.silu(c)
    for i in range(DEPTH):
        mod = cond @ ada_w[i] + ada_b[i]
        sh1, sc1, g1, sh2, sc2, g2 = jnp.split(mod[:, None, :], 6, axis=-1)
        h = rms_norm(x, norm1_g[i]) * (1.0 + sc1) + sh1
        kind, j = i % N_MIXERS, i // N_MIXERS
        if kind == 0:
            y = mixer_swa(h, swa_w_in[j], swa_qn_g[j], swa_kn_g[j], swa_sinks[j], swa_w_out[j])
        elif kind == 1:
            y = mixer_dsa(h, dsa_w_in[j], dsa_qlat_g[j], dsa_kvlat_g[j], dsa_w_uq[j], dsa_w_ukv[j],
                          dsa_w_idx_q[j], dsa_qn_g[j], dsa_kn_g[j], dsa_w_out[j])
        else:
            y = mixer_dilated(h, dil_w_in[j], dil_qn_g[j], dil_kn_g[j], dil_w_out[j])
        x = x + g1 * y
        h = rms_norm(x, norm2_g[i]) * (1.0 + sc2) + sh2
        x = x + g2 * squared_relu_mlp(h, mlp_w1[i], mlp_w2[i])
    return x
```

```cpp
#include <hip/hip_runtime.h>
#include <cstdio>
#include <cstdint>
#include <cmath>
namespace pg8 {
#define PG8_LAS __attribute__((address_space(3)))
typedef unsigned short bf16_t;
typedef short bf16x8 __attribute__((ext_vector_type(8)));
typedef float f32x4 __attribute__((ext_vector_type(4)));
typedef unsigned u32x4 __attribute__((ext_vector_type(4)));
constexpr int BM = 256, BK = 64, HALF = 128, HTB = HALF * BK * 2  , STAGE_BYTES = 8 * HTB, NXCD = 8, WGM = 8;

__host__ __device__ __forceinline__ int lds_byte(int r, int c) { const int st = (r >> 4) * 2 + (c >> 5), rr = r & 15, cc = c & 31, ob = rr * 64 + cc * 2; return st * 1024 + (ob ^ (((ob >> 9) & 1) << 5)); }
__host__ __device__ __forceinline__ void stage_rc(int b, int& R, int& C) { const int st = b / 1024, sb = b % 1024, swz = sb ^ (((sb >> 9) & 1) << 5); R = (st >> 1) * 16 + swz / 64; C = (st & 1) * 32 + (swz % 64) / 2; }
__host__ __device__ __forceinline__ int perm32(int rho) { const int n = rho >> 4, i = rho & 15; return 8 * (i >> 2) + 4 * n + (i & 3); }

struct Unit { int pm, pn; };
struct Gemm { const bf16_t* A; const bf16_t* Bt; int M, N, K; };

struct StaticOrder {
    int nM, nN, nwg, G, c;
    __host__ __device__ void init(int M, int N, int G_, int c_) { nM = M / BM; nN = N / BM; nwg = nM * nN; G = G_; c = c_; }
    __host__ __device__ bool next(int i, Unit& u) const {
        const long L = (long)i * G + c; if (L >= nwg) return false;
        int wgid = (int)L; { const int q = nwg / NXCD, r = nwg % NXCD, xcd = wgid % NXCD, off = wgid / NXCD; wgid = (xcd < r ? xcd * (q + 1) : r * (q + 1) + (xcd - r) * q) + off; }
        const int nig = WGM * nN, gid = wgid / nig, fm = gid * WGM, gsz = (nM - fm) < WGM ? (nM - fm) : WGM;
        u.pm = fm + ((wgid % nig) % gsz); u.pn = (wgid % nig) / gsz; return true;
    }
    __device__ __forceinline__ void a_ready(const Unit&) const {}
    __device__ __forceinline__ void done(const Unit&) const {}
};
__device__ __forceinline__ unsigned cvt_pk_bf16(float lo, float hi) { unsigned r; asm volatile("v_cvt_pk_bf16_f32 %0, %1, %2" : "=v"(r) : "v"(lo), "v"(hi)); return r; }
typedef float f32x2 __attribute__((ext_vector_type(2)));
template <int ACT  > struct EpiBf16S {
    static constexpr bool PERM = true, AFTER_DRAIN = false;
    bf16_t* O; int ldc;
    __device__ __forceinline__ void operator()(const f32x4 (&acc)[2][2][4][2], const Unit& u, int wr, int wc, int fr, int fq) const {
        const int row0 = u.pm * BM + wr * 64 + fr, col0 = u.pn * BM + wc * 32 + 8 * fq;
#pragma unroll
        for (int ai = 0; ai < 2; ++ai)
#pragma unroll
            for (int m = 0; m < 4; ++m) { bf16_t* rowp = O + (size_t)(row0 + ai * HALF + m * 16) * ldc + col0;
#pragma unroll
                for (int bj = 0; bj < 2; ++bj) { f32x4 v0 = acc[ai][bj][m][0], v1 = acc[ai][bj][m][1];
                    if (ACT == 1) {
#pragma unroll
                        for (int e = 0; e < 4; ++e) { const float a = fmaxf(v0[e], 0.f), b = fmaxf(v1[e], 0.f); v0[e] = a * a; v1[e] = b * b; } }
                    u32x4 w; w.x = cvt_pk_bf16(v0[0], v0[1]); w.y = cvt_pk_bf16(v0[2], v0[3]); w.z = cvt_pk_bf16(v1[0], v1[1]); w.w = cvt_pk_bf16(v1[2], v1[3]);
                    *(u32x4*)(rowp + bj * HALF) = w; } }
    }
};
struct EpiResGate {
    static constexpr bool PERM = false, AFTER_DRAIN = false;
    const float* base; float* out; int ldc; const float* gate; int gate_bstride; int rows_per_batch;
    __device__ __forceinline__ void operator()(const f32x4 (&acc)[2][2][4][2], const Unit& u, int wr, int wc, int fr, int fq) const {
        const int row0 = u.pm * BM + wr * 64 + fr, col0 = u.pn * BM + wc * 32 + 4 * fq;
        const float* gp = gate + (size_t)((u.pm * BM) / rows_per_batch) * gate_bstride + col0;
        f32x4 gv[2][2];
#pragma unroll
        for (int bj = 0; bj < 2; ++bj)
#pragma unroll
            for (int n = 0; n < 2; ++n) gv[bj][n] = *(const f32x4*)(gp + bj * HALF + n * 16);
#pragma unroll
        for (int ai = 0; ai < 2; ++ai)
#pragma unroll
            for (int m = 0; m < 4; ++m) { const size_t off = (size_t)(row0 + ai * HALF + m * 16) * ldc + col0;
#pragma unroll
                for (int bj = 0; bj < 2; ++bj)
#pragma unroll
                    for (int n = 0; n < 2; ++n) { const f32x4 bs = *(const f32x4*)(base + off + bj * HALF + n * 16); *(f32x4*)(out + off + bj * HALF + n * 16) = bs + gv[bj][n] * acc[ai][bj][m][n]; } }
    }
};
template <class Epi, class Sched, bool ALIGN_EPI = false, bool SP2 = false>
__device__ __forceinline__ void gemm_phase(PG8_LAS unsigned char* lds, const Gemm g, const Sched& S, const Epi& E) {
    int tid_ = threadIdx.x; asm volatile("" : "+v"(tid_));
    const int tid = tid_, wid = __builtin_amdgcn_readfirstlane(tid >> 6), lane = tid & 63, wr = wid >> 2, wc = wid & 3, fr = lane & 15, fq = lane >> 4;
    const int K = g.K, nt = K / BK;
    unsigned voffA[2], voffB[2];
#pragma unroll
    for (int i = 0; i < 2; ++i) { int R, C; stage_rc(tid * 16 + i * 8192, R, C); const int Rb = Epi::PERM ? ((R & ~31) + perm32(R & 31)) : R;
        voffA[i] = (unsigned)(R * K + C) * 2u; voffB[i] = (unsigned)(Rb * K + C) * 2u; }
    const size_t kstep = (size_t)(BK * 2);
    const size_t hstep = (size_t)HALF * K * 2;
    const size_t tstep = 2 * hstep;
    const unsigned ldsw = (unsigned)wid * 1024u;
    const int aoff = lds_byte(wr * 64 + fr, fq * 8), boff = lds_byte(wc * 32 + fr, fq * 8);
#define PG8_SA(b, h) (((b) * 2 + (h)) * HTB)
#define PG8_SB(b, h) ((4 + (b) * 2 + (h)) * HTB)
#define PG8_STAGE(bufoff, gbase, voff) do { _Pragma("unroll") for (int _i = 0; _i < 2; ++_i) \
        __builtin_amdgcn_global_load_lds((const unsigned*)((const char*)(gbase) + (voff)[_i]), (PG8_LAS unsigned*)(lds + (bufoff) + ldsw + _i * 8192), 16, 0, 0); } while (0)
#define PG8_LDA(dst, b, h) do { _Pragma("unroll") for (int m = 0; m < 4; ++m) _Pragma("unroll") for (int k = 0; k < 2; ++k) dst[m][k] = *(const PG8_LAS bf16x8*)(lds + PG8_SA(b, h) + aoff + m * 2048 + k * 1024); } while (0)
#define PG8_LDB(dst, b, h) do { _Pragma("unroll") for (int n = 0; n < 2; ++n) _Pragma("unroll") for (int k = 0; k < 2; ++k) dst[n][k] = *(const PG8_LAS bf16x8*)(lds + PG8_SB(b, h) + boff + n * 2048 + k * 1024); } while (0)
#define PG8_MMA(ai, bj, At, Bt) do { __builtin_amdgcn_s_setprio(1); _Pragma("unroll") for (int m = 0; m < 4; ++m) _Pragma("unroll") for (int n = 0; n < 2; ++n) _Pragma("unroll") for (int k = 0; k < 2; ++k) \
        acc[ai][bj][m][n] = __builtin_amdgcn_mfma_f32_16x16x32_bf16(Bt[n][k], At[m][k], acc[ai][bj][m][n], 0, 0, 0); __builtin_amdgcn_s_setprio(0); } while (0)
#define PG8_WAIT_V(n) asm volatile("s_waitcnt vmcnt(" #n ")" ::: "memory")
#define PG8_WAIT_L(n) asm volatile("s_waitcnt lgkmcnt(" #n ")" ::: "memory")
#define PG8_BAR __builtin_amdgcn_s_barrier()
#define PG8_SCHED __builtin_amdgcn_sched_barrier(0)
    Unit cur, nxt; int ui = 0;
    if (!S.next(0, cur)) return;
    f32x4 acc[2][2][4][2];
#pragma unroll
    for (int a = 0; a < 2; ++a)
#pragma unroll
        for (int b = 0; b < 2; ++b)
#pragma unroll
            for (int m = 0; m < 4; ++m)
#pragma unroll
                for (int n = 0; n < 2; ++n) acc[a][b][m][n] = (f32x4){0.f, 0.f, 0.f, 0.f};
    bf16x8 At[4][2], B0[2][2], B1[2][2];
    const char* cA = (const char*)g.A + (size_t)cur.pm * tstep; const char* cB = (const char*)g.Bt + (size_t)cur.pn * tstep;
    S.a_ready(cur);
    if constexpr (SP2) {
        PG8_STAGE(PG8_SB(0, 0), cB, voffB); PG8_STAGE(PG8_SB(0, 1), cB + hstep, voffB); PG8_STAGE(PG8_SA(0, 0), cA, voffA); PG8_STAGE(PG8_SA(0, 1), cA + hstep, voffA);
        if (wr == 1) PG8_BAR;
        PG8_WAIT_V(2); PG8_BAR;
        PG8_STAGE(PG8_SB(1, 0), cB + kstep, voffB); PG8_STAGE(PG8_SA(1, 0), cA + kstep, voffA); PG8_STAGE(PG8_SB(1, 1), cB + hstep + kstep, voffB);
        PG8_WAIT_V(6); PG8_BAR;
    } else {
        PG8_STAGE(PG8_SB(0, 0), cB, voffB); PG8_STAGE(PG8_SA(0, 0), cA, voffA); PG8_STAGE(PG8_SB(0, 1), cB + hstep, voffB); PG8_STAGE(PG8_SA(0, 1), cA + hstep, voffA);
        if (wr == 1) PG8_BAR;
        PG8_WAIT_V(4); PG8_BAR;
        PG8_STAGE(PG8_SB(1, 0), cB + kstep, voffB); PG8_STAGE(PG8_SA(1, 0), cA + kstep, voffA); PG8_STAGE(PG8_SB(1, 1), cB + hstep + kstep, voffB);
        PG8_WAIT_V(6); PG8_BAR;
    }
    for (;;) {
        const bool has_next = S.next(ui + 1, nxt);
        const char* nA = has_next ? (const char*)g.A + (size_t)nxt.pm * tstep : cA; const char* nB = has_next ? (const char*)g.Bt + (size_t)nxt.pn * tstep : cB;
        for (int t = 0; t < nt; t += 2) {
            const bool last = (t == nt - 2);
            const char* a1 = cA + (size_t)(t + 1) * kstep;
            const char* a2 = last ? nA : cA + (size_t)(t + 2) * kstep; const char* b2 = last ? nB : cB + (size_t)(t + 2) * kstep;
            const char* a3 = a2 + kstep; const char* b3 = b2 + kstep;
            if (last && has_next) S.a_ready(nxt);
            if constexpr (SP2) {
            PG8_LDB(B0, 0, 0); PG8_LDB(B1, 0, 1); PG8_SCHED; PG8_LDA(At, 0, 0); PG8_STAGE(PG8_SA(1, 1), a1 + hstep, voffA);
            PG8_WAIT_V(8); PG8_WAIT_L(0); PG8_BAR; PG8_MMA(0, 0, At, B0); PG8_MMA(0, 1, At, B1); PG8_BAR; PG8_SCHED;
            PG8_LDA(At, 0, 1); PG8_STAGE(PG8_SB(0, 0), b2, voffB); PG8_STAGE(PG8_SB(0, 1), b2 + hstep, voffB); PG8_STAGE(PG8_SA(0, 0), a2, voffA);
            PG8_WAIT_V(8); PG8_WAIT_L(0); PG8_BAR; PG8_MMA(1, 0, At, B0); PG8_MMA(1, 1, At, B1); PG8_BAR; PG8_SCHED;
            PG8_LDB(B0, 1, 0); PG8_LDB(B1, 1, 1); PG8_SCHED; PG8_LDA(At, 1, 0); PG8_STAGE(PG8_SA(0, 1), a2 + hstep, voffA);
            PG8_WAIT_V(8); PG8_WAIT_L(0); PG8_BAR; PG8_MMA(0, 0, At, B0); PG8_MMA(0, 1, At, B1); PG8_BAR; PG8_SCHED;
            PG8_LDA(At, 1, 1); PG8_STAGE(PG8_SB(1, 0), b3, voffB); PG8_STAGE(PG8_SB(1, 1), b3 + hstep, voffB); PG8_STAGE(PG8_SA(1, 0), a3, voffA);
            PG8_WAIT_V(8); PG8_WAIT_L(0); PG8_BAR; PG8_MMA(1, 0, At, B0); PG8_MMA(1, 1, At, B1); PG8_BAR; PG8_SCHED;
            } else {
            PG8_LDB(B0, 0, 0); PG8_SCHED; PG8_LDA(At, 0, 0); PG8_STAGE(PG8_SA(1, 1), a1 + hstep, voffA);
            PG8_WAIT_L(8); PG8_BAR; PG8_WAIT_L(0); PG8_MMA(0, 0, At, B0); PG8_BAR; PG8_SCHED;
            PG8_LDB(B1, 0, 1); PG8_STAGE(PG8_SB(0, 0), b2, voffB);
            PG8_BAR; PG8_WAIT_L(0); PG8_MMA(0, 1, At, B1); PG8_BAR;
            PG8_LDA(At, 0, 1); PG8_STAGE(PG8_SA(0, 0), a2, voffA);
            PG8_BAR; PG8_WAIT_L(0); PG8_MMA(1, 0, At, B0); PG8_BAR; PG8_SCHED;
            PG8_STAGE(PG8_SB(0, 1), b2 + hstep, voffB);
            PG8_WAIT_V(6); PG8_BAR; PG8_MMA(1, 1, At, B1); PG8_BAR;
            PG8_LDB(B0, 1, 0); PG8_SCHED; PG8_LDA(At, 1, 0); PG8_STAGE(PG8_SA(0, 1), a2 + hstep, voffA);
            PG8_WAIT_L(8); PG8_BAR; PG8_WAIT_L(0); PG8_MMA(0, 0, At, B0); PG8_BAR; PG8_SCHED;
            PG8_LDB(B1, 1, 1); PG8_STAGE(PG8_SB(1, 0), b3, voffB);
            PG8_BAR; PG8_WAIT_L(0); PG8_MMA(0, 1, At, B1); PG8_BAR;
            PG8_LDA(At, 1, 1); PG8_STAGE(PG8_SA(1, 0), a3, voffA);
            PG8_BAR; PG8_WAIT_L(0); PG8_MMA(1, 0, At, B0); PG8_BAR; PG8_SCHED;
            PG8_STAGE(PG8_SB(1, 1), b3 + hstep, voffB);
            PG8_WAIT_V(6); PG8_BAR; PG8_MMA(1, 1, At, B1); PG8_BAR;
            }
        }
        if constexpr (ALIGN_EPI) { if (wr == 0) PG8_BAR; }
        if constexpr (!Epi::AFTER_DRAIN) { E(acc, cur, wr, wc, fr, fq); S.done(cur); }
        if (!has_next) break;
#pragma unroll
        for (int a = 0; a < 2; ++a)
#pragma unroll
            for (int b = 0; b < 2; ++b)
#pragma unroll
                for (int m = 0; m < 4; ++m)
#pragma unroll
                    for (int n = 0; n < 2; ++n) acc[a][b][m][n] = (f32x4){0.f, 0.f, 0.f, 0.f};
        cur = nxt; cA = nA; cB = nB; ++ui;
        if constexpr (ALIGN_EPI) { if (wr == 1) PG8_BAR; }
    }
    PG8_WAIT_V(0);
    if constexpr (!ALIGN_EPI) { if (wr == 0) PG8_BAR; }
    PG8_BAR;
    if constexpr (Epi::AFTER_DRAIN) { E.fused(acc, cur, wr, wc, fr, fq, lds, wid, lane); S.done(cur); }
#undef PG8_SA
#undef PG8_SB
#undef PG8_STAGE
#undef PG8_LDA
#undef PG8_LDB
#undef PG8_MMA
#undef PG8_WAIT_V
#undef PG8_WAIT_L
#undef PG8_BAR
#undef PG8_SCHED
}
}
constexpr int NWAVES = 8, NT = NWAVES * 64;
constexpr int BATCH = 8, S = 2048, D = 2048, M = BATCH * S, FF = 8192, DEPTH = 4;
constexpr int SWA_IN = 2560, DSA_INP = 1024  , DSA_IN_SRC = 848, DIL_IN = 4608, DSA_QQ = 3072;
constexpr float EPS = 1e-6f;
constexpr size_t MiB = 1u << 20;
constexpr size_t WS_CTL = 0, CTL_ZERO_BYTES = 1 * MiB;
constexpr size_t WS_MOD = 1 * MiB;
constexpr size_t WS_W1T = 4 * MiB, WS_W2T = 132 * MiB;
constexpr size_t WS_SWA_IN_T = 260 * MiB, WS_SWA_OUT_T = 280 * MiB;
constexpr size_t WS_DSA_IN_T = 296 * MiB, WS_DSA_UQ_T = 300 * MiB, WS_DSA_UKV_T = 303 * MiB, WS_DSA_OUT_T = 304 * MiB;
constexpr size_t WS_DIL_IN_T = 312 * MiB, WS_DIL_OUT_T = 330 * MiB;
constexpr size_t WS_H = 334 * MiB;
constexpr size_t WS_BIG = 398 * MiB;
constexpr size_t WS_PROJ = WS_BIG;
constexpr size_t WS_O = WS_BIG + 192 * MiB;
constexpr size_t WS_LAT = WS_BIG, WS_QL = WS_BIG + 32 * MiB, WS_KVL = WS_BIG + 48 * MiB, WS_KV = WS_BIG + 56 * MiB, WS_IDX = WS_BIG + 64 * MiB, WS_NSEL = WS_BIG + 72 * MiB, WS_QQ = WS_BIG + 80 * MiB;
constexpr size_t WS_END = 654 * MiB;
constexpr int CW_BAR = 4096;
constexpr int RING_OFF = 0, RING_BYTES = 131072;
constexpr int LDSCTL_OFF = RING_BYTES, MISC_OFF = LDSCTL_OFF + 320;
constexpr int LDS_BYTES = 147456;

#define GAS __attribute__((address_space(1)))
#define LAS __attribute__((address_space(3)))
typedef unsigned short bf16;
typedef unsigned v4u __attribute__((ext_vector_type(4)));
typedef unsigned v2u __attribute__((ext_vector_type(2)));
typedef float f32x4 __attribute__((ext_vector_type(4)));
#define LDS_WAIT() asm volatile("s_waitcnt lgkmcnt(0)" ::: "memory")
#define VM_WAIT() asm volatile("s_waitcnt vmcnt(0)" ::: "memory")
__device__ __forceinline__ unsigned f2bf(float f) { unsigned u = __builtin_bit_cast(unsigned, f); return (u + 0x7fffu + ((u >> 16) & 1u)) >> 16; }
__device__ __forceinline__ unsigned pk2(float lo, float hi) { return f2bf(lo) | (f2bf(hi) << 16); }
__device__ __forceinline__ float bflo(unsigned w) { return __uint_as_float(w << 16); }
__device__ __forceinline__ float bfhi(unsigned w) { return __uint_as_float(w & 0xffff0000u); }
__device__ __forceinline__ float bf2f(bf16 v) { return __uint_as_float((unsigned)v << 16); }
__device__ __forceinline__ void unpack8(const v4u w, float* f) { f[0] = bflo(w.x); f[1] = bfhi(w.x); f[2] = bflo(w.y); f[3] = bfhi(w.y); f[4] = bflo(w.z); f[5] = bfhi(w.z); f[6] = bflo(w.w); f[7] = bfhi(w.w); }
__device__ __forceinline__ float wave_sum(float v) {
#pragma unroll
    for (int o = 1; o < 64; o <<= 1) v += __shfl_xor(v, o);
    return v;
}
__device__ __forceinline__ float wave_max(float v) {
#pragma unroll
    for (int o = 1; o < 64; o <<= 1) v = fmaxf(v, __shfl_xor(v, o));
    return v;
}
#define XB_TMO      128
#define XB_XCNT(j)  (256  + 64 * (j))
#define XB_XSUB(j)  (1280 + 64 * (j))
#define XB_XGEN(j)  (2304 + 64 * (j))
#define XB_TOP      3328
#define XB_TOPGEN   3392
#define XCD_BAR_WORDS 3456
#define XB_SPIN_CAP (1u << 18)

__device__ __forceinline__ unsigned xb_ld(unsigned* p)              { return __hip_atomic_load(p, __ATOMIC_RELAXED, __HIP_MEMORY_SCOPE_AGENT); }
__device__ __forceinline__ unsigned xb_add(unsigned* p, unsigned v) { return __hip_atomic_fetch_add(p, v, __ATOMIC_RELAXED, __HIP_MEMORY_SCOPE_AGENT); }
__device__ __forceinline__ unsigned xb_xcc_id() { return (unsigned)__builtin_amdgcn_s_getreg((3 << 11) | 20) & 0xFu; }
#define XB_SPIN(cond, bar) do { unsigned _sp = 0; while (cond) { __builtin_amdgcn_s_sleep(1); \
    if ((++_sp & 255u) == 0u) { if (xb_ld(&(bar)[XB_TMO])) break; if (_sp > XB_SPIN_CAP) { atomicAdd(&(bar)[XB_TMO], 1u); break; } } } } while (0)

struct XcdBarrier {
    unsigned* bar; unsigned x;
    volatile LAS unsigned* st;
};

__device__ __forceinline__ XcdBarrier xcd_barrier_post(unsigned* bar, volatile LAS unsigned* st) {
    XcdBarrier b; b.bar = bar; b.x = xb_xcc_id(); b.st = st;
    if (threadIdx.x == 0) (void)xb_add(&bar[XB_XCNT(b.x)], 1u);
    return b;
}
__device__ __forceinline__ void xcd_barrier_complete(unsigned* bar, unsigned x, unsigned& nloc, unsigned& nx) {
    const unsigned G = gridDim.x * gridDim.y * gridDim.z;
    unsigned sum, cnt, mine, sp = 0u;
    for (;;) {
        sum = 0u; cnt = 0u; mine = 0u;
#pragma unroll
        for (unsigned j = 0; j < 16; ++j) { const unsigned c = xb_ld(&bar[XB_XCNT(j)]); sum += c; cnt += (c > 0u) ? 1u : 0u; mine = (j == x) ? c : mine; }
        if (sum == G) break;
        __builtin_amdgcn_s_sleep(1);
        if ((++sp & 255u) == 0u) { if (xb_ld(&bar[XB_TMO])) break; if (sp > XB_SPIN_CAP) { atomicAdd(&bar[XB_TMO], 1u); break; } }
    }
    nloc = mine > 0u ? mine : 1u; nx = cnt > 0u ? cnt : 1u;
}

__device__ __forceinline__ void xcd_barrier(const XcdBarrier& b) {
    asm volatile("s_waitcnt vmcnt(0)" ::: "memory");
    __syncthreads();
    if (threadIdx.x == 0) {
        unsigned* bar = b.bar;
        __builtin_amdgcn_s_waitcnt(0);
        unsigned nloc = b.st[0], nx = b.st[1];
        if (nloc == 0u) { xcd_barrier_complete(bar, b.x, nloc, nx); b.st[0] = nloc; b.st[1] = nx; }
        const unsigned old = xb_add(&bar[XB_XSUB(b.x)], 1u);
        const unsigned gen = old / nloc;
        if (old + 1u == (gen + 1u) * nloc) {
            __builtin_amdgcn_fence(__ATOMIC_RELEASE, "agent");
            asm volatile("s_waitcnt vmcnt(0)" ::: "memory");
            const unsigned og = xb_add(&bar[XB_TOP], 1u);
            const unsigned tg = og / nx;
            if (og + 1u == (tg + 1u) * nx) xb_add(&bar[XB_TOPGEN], 1u);
            else XB_SPIN(xb_ld(&bar[XB_TOPGEN]) == tg, bar);
            __builtin_amdgcn_fence(__ATOMIC_ACQUIRE, "agent");
            xb_add(&bar[XB_XGEN(b.x)], 1u);
            asm volatile("s_waitcnt vmcnt(0)" ::: "memory");
        } else {
            XB_SPIN(xb_ld(&bar[XB_XGEN(b.x)]) == gen, bar);
            __builtin_amdgcn_fence(__ATOMIC_ACQUIRE, "agent");
            asm volatile("s_waitcnt vmcnt(0)" ::: "memory");
        }
    }
    __syncthreads();
}
struct Frame {
    LAS unsigned char* lds;
    int tid, lane, wave, G, gw, NGW;
};

__device__ __forceinline__ void p0_ada(Frame& F, const float* c, const float* ada_w, const float* ada_b, float* mod) {
    LAS float* cond = (LAS float*)(F.lds + RING_OFF);
    LAS float* red = (LAS float*)(F.lds + RING_OFF + 65536);
    for (int i = F.tid; i < 8 * 2048; i += NT) { const int b = i >> 11, k = i & 2047; const float v = c[i]; cond[k * 8 + b] = v / (1.f + __expf(-v)); }
    __syncthreads();
    constexpr int NSLAB = DEPTH * 64;
    for (int slab = blockIdx.x; slab < NSLAB; slab += F.G) {
        const int layer = slab >> 6, col0 = (slab & 63) * 192;
        const float* W = ada_w + (size_t)layer * 2048 * 12288 + col0 + F.lane;
        float acc[3][8];
#pragma unroll
        for (int j = 0; j < 3; ++j)
#pragma unroll
            for (int b = 0; b < 8; ++b) acc[j][b] = 0.f;
        const int k0 = F.wave * 256;
        for (int k = k0; k < k0 + 256; k += 8) {
            float w[8][3];
#pragma unroll
            for (int kk = 0; kk < 8; ++kk)
#pragma unroll
                for (int j = 0; j < 3; ++j) w[kk][j] = W[(size_t)(k + kk) * 12288 + 64 * j];
#pragma unroll
            for (int kk = 0; kk < 8; ++kk) {
                const f32x4 c0 = *(const LAS f32x4*)(cond + (k + kk) * 8), c1 = *(const LAS f32x4*)(cond + (k + kk) * 8 + 4);
#pragma unroll
                for (int j = 0; j < 3; ++j) {
                    acc[j][0] += w[kk][j] * c0[0]; acc[j][1] += w[kk][j] * c0[1]; acc[j][2] += w[kk][j] * c0[2]; acc[j][3] += w[kk][j] * c0[3];
                    acc[j][4] += w[kk][j] * c1[0]; acc[j][5] += w[kk][j] * c1[1]; acc[j][6] += w[kk][j] * c1[2]; acc[j][7] += w[kk][j] * c1[3]; }
            }
        }
#pragma unroll
        for (int j = 0; j < 3; ++j)
#pragma unroll
            for (int b = 0; b < 8; ++b) red[(F.wave * 8 + b) * 192 + j * 64 + F.lane] = acc[j][b];
        __syncthreads();
        for (int o = F.tid; o < 8 * 192; o += NT) { const int b = o / 192, cc = o % 192; float s = 0.f;
#pragma unroll
            for (int w = 0; w < 8; ++w) s += red[(w * 8 + b) * 192 + cc];
            mod[(size_t)(layer * 8 + b) * 12288 + col0 + cc] = s + ada_b[layer * 12288 + col0 + cc]; }
        __syncthreads();
    }
}

__device__ __forceinline__ void p0_transpose_item(const float* W, int K, int Nsrc, int Npad, bf16* WT, int row_off, LAS float* scr, int item, int lane) {
    const int nblk = Npad / 32, kb = item / nblk, nb = item % nblk, k0 = 64 * kb, n0 = 32 * nb;
    const int nc = n0 + (lane & 31); const bool ok = nc < Nsrc;
#pragma unroll 8
    for (int i = 0; i < 32; ++i) { const int kk = 2 * i + (lane >> 5); scr[kk * 33 + (lane & 31)] = ok ? W[(size_t)(k0 + kk) * Nsrc + nc] : 0.f; }
    LDS_WAIT(); asm volatile("" ::: "memory");
    const int cch = lane & 7;
#pragma unroll
    for (int j = 0; j < 4; ++j) { const int n = (lane >> 3) + 8 * j; const LAS float* s = scr + (8 * cch) * 33 + n;
        v4u o; o.x = pk2(s[0 * 33], s[1 * 33]); o.y = pk2(s[2 * 33], s[3 * 33]); o.z = pk2(s[4 * 33], s[5 * 33]); o.w = pk2(s[6 * 33], s[7 * 33]);
        *(GAS v4u*)(WT + (size_t)(row_off + n0 + n) * K + k0 + 8 * cch) = o; }
    LDS_WAIT(); asm volatile("" ::: "memory");
}
struct TJob { const float* src; bf16* dst; int K, Nsrc, Npad, row_off, items; };
__device__ __forceinline__ void p0_weights(Frame& F, const float* const* in, unsigned char* ws) {
    LAS float* scr = (LAS float*)(F.lds + RING_OFF + F.wave * 16384);
    constexpr int NJOB = 19;
    for (int it = F.gw; ; it += F.NGW) {
        int r = it; TJob jb; bool found = false;
#pragma unroll
        for (int q = 0; q < NJOB; ++q) {
            TJob t;
            if (q < 4)       t = TJob{in[6] + (size_t)q * D * FF, (bf16*)(ws + WS_W1T) + (size_t)q * FF * D, D, FF, FF, 0, (D / 64) * (FF / 32)};
            else if (q < 8)  t = TJob{in[7] + (size_t)(q - 4) * FF * D, (bf16*)(ws + WS_W2T) + (size_t)(q - 4) * D * FF, FF, D, D, 0, (FF / 64) * (D / 32)};
            else if (q < 10) t = TJob{in[8] + (size_t)(q - 8) * D * SWA_IN, (bf16*)(ws + WS_SWA_IN_T) + (size_t)(q - 8) * SWA_IN * D, D, SWA_IN, SWA_IN, 0, (D / 64) * (SWA_IN / 32)};
            else if (q < 12) t = TJob{in[12] + (size_t)(q - 10) * D * D, (bf16*)(ws + WS_SWA_OUT_T) + (size_t)(q - 10) * D * D, D, D, D, 0, (D / 64) * (D / 32)};
            else if (q == 12) t = TJob{in[13], (bf16*)(ws + WS_DSA_IN_T), D, DSA_IN_SRC, DSA_INP, 0, (D / 64) * (DSA_INP / 32)};
            else if (q == 13) t = TJob{in[16], (bf16*)(ws + WS_DSA_UQ_T), 512, 2048, 2048, 0, (512 / 64) * (2048 / 32)};
            else if (q == 14) t = TJob{in[18], (bf16*)(ws + WS_DSA_UQ_T), 512, 1024, 1024, 2048, (512 / 64) * (1024 / 32)};
            else if (q == 15) t = TJob{in[17], (bf16*)(ws + WS_DSA_UKV_T), 256, 256, 256, 0, (256 / 64) * (256 / 32)};
            else if (q == 16) t = TJob{in[21], (bf16*)(ws + WS_DSA_OUT_T), D, D, D, 0, (D / 64) * (D / 32)};
            else if (q == 17) t = TJob{in[22], (bf16*)(ws + WS_DIL_IN_T), D, DIL_IN, DIL_IN, 0, (D / 64) * (DIL_IN / 32)};
            else              t = TJob{in[25], (bf16*)(ws + WS_DIL_OUT_T), 1024, D, D, 0, (1024 / 64) * (D / 32)};
            if (!found) { if (r < t.items) { jb = t; found = true; } else r -= t.items; }
        }
        if (!found) break;
        p0_transpose_item(jb.src, jb.K, jb.Nsrc, jb.Npad, jb.dst, jb.row_off, scr, r, F.lane);
    }
}

__device__ __forceinline__ void norm_phase(Frame& F, const float* x, const float* gain, const float* modl, int sh_off, int sc_off, bf16* H) {
    for (int rg = F.gw; rg < M / 8; rg += F.NGW) {
        const int m0 = rg * 8, b = m0 / S;
        const float* mb = modl + (size_t)b * 12288;
        f32x4 A[8], Sh[8];
#pragma unroll
        for (int j = 0; j < 8; ++j) { const int col = 4 * (F.lane + 64 * j); const f32x4 g = *(const f32x4*)(gain + col), sc = *(const f32x4*)(mb + sc_off + col); Sh[j] = *(const f32x4*)(mb + sh_off + col); A[j] = g * (sc + 1.0f); }
        for (int r = 0; r < 8; ++r) {
            const GAS f32x4* xr = (const GAS f32x4*)(x + (size_t)(m0 + r) * D) + F.lane;
            f32x4 v[8]; float ss = 0.f;
#pragma unroll
            for (int j = 0; j < 8; ++j) { v[j] = xr[64 * j]; ss += (v[j].x * v[j].x + v[j].y * v[j].y) + (v[j].z * v[j].z + v[j].w * v[j].w); }
            const float rstd = 1.0f / sqrtf(wave_sum(ss) * (1.f / D) + EPS);
            GAS v2u* o8 = (GAS v2u*)(H + (size_t)(m0 + r) * D) + F.lane;
#pragma unroll
            for (int j = 0; j < 8; ++j) { const f32x4 h = v[j] * rstd * A[j] + Sh[j]; v2u w; w.x = pk2(h.x, h.y); w.y = pk2(h.z, h.w); o8[64 * j] = w; }
        }
    }
}

template <int KIND>
__device__ __forceinline__ void qknorm_phase(Frame& F, bf16* P, int pitch, const float* qn, const float* kn) {
    constexpr int NCOLS = KIND == 0 ? 2304 : DIL_IN;
    for (int m = F.gw; m < M; m += F.NGW) {
        bf16* row = P + (size_t)m * pitch;
        for (int c0 = 0; c0 < NCOLS; c0 += 512) {
            const int col = c0 + 8 * F.lane;
            bool act; const float* g;
            if (KIND == 0) { act = col < 2304; g = (col < 2048 ? qn : kn) + (col & 63); }
            else { const int gi = col / 1536, cl = col - gi * 1536; act = cl < 1280; g = (cl < 1024 ? qn : kn) + gi * 64 + (col & 63); }
            float f[8]; float ss = 0.f;
            if (act) { const v4u w = *(const GAS v4u*)(row + col); unpack8(w, f);
#pragma unroll
                for (int e = 0; e < 8; ++e) ss += f[e] * f[e]; }
            ss += __shfl_xor(ss, 1); ss += __shfl_xor(ss, 2); ss += __shfl_xor(ss, 4);
            if (act) { const float rstd = 1.0f / sqrtf(ss * (1.f / 64.f) + EPS); const f32x4 g0 = *(const f32x4*)g, g1 = *(const f32x4*)(g + 4);
                v4u o; o.x = pk2(f[0] * rstd * g0.x, f[1] * rstd * g0.y); o.y = pk2(f[2] * rstd * g0.z, f[3] * rstd * g0.w); o.z = pk2(f[4] * rstd * g1.x, f[5] * rstd * g1.y); o.w = pk2(f[6] * rstd * g1.z, f[7] * rstd * g1.w);
                *(GAS v4u*)(row + col) = o; }
        }
    }
}

template <int G, int NSEG, bool SINK>
__device__ __forceinline__ void band_attn_naive(Frame& F, const bf16* P, int pitch, int segstride, int kbase, int vbase, bf16* O, int opitch, const float* sinks, int nslope) {
    constexpr int NSLOT = SINK ? 2 : 3, NKEYS = SINK ? 128 : 129;
    LAS float* qs = (LAS float*)(F.lds + RING_OFF + F.wave * 16384);
    LAS float* ps = qs + NSEG * G * 64;
    for (int item = F.gw; item < M * 4; item += F.NGW) {
        const int m = item >> 2, kvh = item & 3, t = m & (S - 1);
        asm volatile("" ::: "memory");
#pragma unroll
        for (int sg = 0; sg < NSEG; ++sg)
#pragma unroll
            for (int g = 0; g < G; ++g) qs[(sg * G + g) * 64 + F.lane] = bf2f(P[(size_t)m * pitch + sg * segstride + (kvh * G + g) * 64 + F.lane]);
        LDS_WAIT(); asm volatile("" ::: "memory");
        float lg[NSEG][NSLOT][G];
#pragma unroll
        for (int sg = 0; sg < NSEG; ++sg) {
            const int dil = sg == 0 ? 1 : (sg == 1 ? 4 : 16);
#pragma unroll
            for (int sl = 0; sl < NSLOT; ++sl) {
                asm volatile("" ::: "memory");
                const int j = sl * 64 + F.lane; const bool valid = (j < NKEYS) && (t - j * dil >= 0);
                const bf16* kr = P + (size_t)(m - (valid ? j * dil : 0)) * pitch + sg * segstride + kbase + kvh * 64;
                float kf[64];
#pragma unroll
                for (int i = 0; i < 8; ++i) { const v4u w = *(const GAS v4u*)(kr + 8 * i); unpack8(w, kf + 8 * i); }
#pragma unroll
                for (int g = 0; g < G; ++g) { float dot = 0.f;
#pragma unroll
                    for (int d4 = 0; d4 < 16; ++d4) { const f32x4 q4 = *(const LAS f32x4*)(qs + (sg * G + g) * 64 + 4 * d4); dot += kf[4 * d4] * q4.x + kf[4 * d4 + 1] * q4.y + kf[4 * d4 + 2] * q4.z + kf[4 * d4 + 3] * q4.w; }
                    const float slope = exp2f(-8.f * (float)(kvh * G + g + 1) / (float)nslope);
                    lg[sg][sl][g] = valid ? dot * 0.125f - slope * (float)(j * dil) : -INFINITY; }
            }
        }
#pragma unroll
        for (int g = 0; g < G; ++g) {
            float mx = -INFINITY;
#pragma unroll
            for (int sg = 0; sg < NSEG; ++sg)
#pragma unroll
                for (int sl = 0; sl < NSLOT; ++sl) mx = fmaxf(mx, lg[sg][sl][g]);
            mx = wave_max(mx);
            float sk = 0.f; if (SINK) { sk = sinks[kvh * G + g]; mx = fmaxf(mx, sk); }
            float sum = 0.f;
#pragma unroll
            for (int sg = 0; sg < NSEG; ++sg)
#pragma unroll
                for (int sl = 0; sl < NSLOT; ++sl) { const float e = __expf(lg[sg][sl][g] - mx); lg[sg][sl][g] = e; sum += e; }
            sum = wave_sum(sum); if (SINK) sum += __expf(sk - mx);
            const float inv = 1.0f / sum;
#pragma unroll
            for (int sg = 0; sg < NSEG; ++sg)
#pragma unroll
                for (int sl = 0; sl < NSLOT; ++sl) ps[(sg * 192 + sl * 64 + F.lane) * G + g] = lg[sg][sl][g] * inv;
        }
        LDS_WAIT(); asm volatile("" ::: "memory");
        float o[G];
#pragma unroll
        for (int g = 0; g < G; ++g) o[g] = 0.f;
#pragma unroll
        for (int sg = 0; sg < NSEG; ++sg) {
            const int dil = sg == 0 ? 1 : (sg == 1 ? 4 : 16);
            const int jmax = min(NKEYS - 1, t / dil);
            const bf16* vb = P + (size_t)m * pitch + sg * segstride + vbase + kvh * 64 + F.lane;
            for (int j0 = 0; j0 <= jmax; j0 += 8) {
                float v[8];
#pragma unroll
                for (int u = 0; u < 8; ++u) { const int jj = min(j0 + u, jmax); v[u] = bf2f(vb[-(ptrdiff_t)jj * dil * pitch]); }
#pragma unroll
                for (int u = 0; u < 8; ++u)
#pragma unroll
                    for (int g4 = 0; g4 < G; g4 += 4) { const f32x4 p4 = *(const LAS f32x4*)(ps + (sg * 192 + j0 + u) * G + g4); o[g4] += p4.x * v[u]; o[g4 + 1] += p4.y * v[u]; o[g4 + 2] += p4.z * v[u]; o[g4 + 3] += p4.w * v[u]; }
            }
        }
#pragma unroll
        for (int g = 0; g < G; ++g) O[(size_t)m * opitch + (kvh * G + g) * 64 + F.lane] = (bf16)f2bf(o[g]);
    }
}

__device__ __forceinline__ void dsa_latnorm_phase(Frame& F, const bf16* LAT, bf16* QL, bf16* KVL, const float* qg, const float* kvg) {
    for (int m = F.gw; m < M; m += F.NGW) {
        const bf16* row = LAT + (size_t)m * DSA_INP;
        float f[8]; { const v4u w = *(const GAS v4u*)(row + 8 * F.lane); unpack8(w, f); }
        float ss = 0.f;
#pragma unroll
        for (int e = 0; e < 8; ++e) ss += f[e] * f[e];
        const float rq = 1.0f / sqrtf(wave_sum(ss) * (1.f / 512.f) + EPS);
        { const f32x4 g0 = *(const f32x4*)(qg + 8 * F.lane), g1 = *(const f32x4*)(qg + 8 * F.lane + 4);
          v4u o; o.x = pk2(f[0] * rq * g0.x, f[1] * rq * g0.y); o.y = pk2(f[2] * rq * g0.z, f[3] * rq * g0.w); o.z = pk2(f[4] * rq * g1.x, f[5] * rq * g1.y); o.w = pk2(f[6] * rq * g1.z, f[7] * rq * g1.w);
          *(GAS v4u*)(QL + (size_t)m * 512 + 8 * F.lane) = o; }
        float h[8]; float s2 = 0.f; const bool act = F.lane < 32;
        if (act) { const v4u w = *(const GAS v4u*)(row + 512 + 8 * F.lane); unpack8(w, h);
#pragma unroll
            for (int e = 0; e < 8; ++e) s2 += h[e] * h[e]; }
        s2 += __shfl_xor(s2, 1); s2 += __shfl_xor(s2, 2); s2 += __shfl_xor(s2, 4); s2 += __shfl_xor(s2, 8); s2 += __shfl_xor(s2, 16);
        if (act) { const float rk = 1.0f / sqrtf(s2 * (1.f / 256.f) + EPS); const f32x4 g0 = *(const f32x4*)(kvg + 8 * F.lane), g1 = *(const f32x4*)(kvg + 8 * F.lane + 4);
          v4u o; o.x = pk2(h[0] * rk * g0.x, h[1] * rk * g0.y); o.y = pk2(h[2] * rk * g0.z, h[3] * rk * g0.w); o.z = pk2(h[4] * rk * g1.x, h[5] * rk * g1.y); o.w = pk2(h[6] * rk * g1.z, h[7] * rk * g1.w);
          *(GAS v4u*)(KVL + (size_t)m * 256 + 8 * F.lane) = o; }
    }
}

__device__ __forceinline__ void dsa_qknorm(Frame& F, bf16* QQ, bf16* KV, const float* qn, const float* kn) {
    for (int m = F.gw; m < M; m += F.NGW) {
#pragma unroll
        for (int c = 0; c < 5; ++c) {
            const bool act = c < 4 || F.lane < 16;
            bf16* p = c < 4 ? QQ + (size_t)m * DSA_QQ + 512 * c + 8 * F.lane : KV + (size_t)m * 256 + 8 * F.lane;
            const float* g = (c < 4 ? qn : kn) + ((8 * F.lane) & 127);
            float f[8]; float ss = 0.f;
            if (act) { const v4u w = *(const GAS v4u*)p; unpack8(w, f);
#pragma unroll
                for (int e = 0; e < 8; ++e) ss += f[e] * f[e]; }
            ss += __shfl_xor(ss, 1); ss += __shfl_xor(ss, 2); ss += __shfl_xor(ss, 4); ss += __shfl_xor(ss, 8);
            if (act) { const float r = 1.0f / sqrtf(ss * (1.f / 128.f) + EPS); const f32x4 g0 = *(const f32x4*)g, g1 = *(const f32x4*)(g + 4);
                v4u o; o.x = pk2(f[0] * r * g0.x, f[1] * r * g0.y); o.y = pk2(f[2] * r * g0.z, f[3] * r * g0.w); o.z = pk2(f[4] * r * g1.x, f[5] * r * g1.y); o.w = pk2(f[6] * r * g1.z, f[7] * r * g1.w);
                *(GAS v4u*)p = o; }
        }
    }
}

__device__ __forceinline__ unsigned f2key(float x) { const unsigned u = __float_as_uint(x); return (u & 0x80000000u) ? ~u : (u | 0x80000000u); }
__device__ __forceinline__ void dsa_index_naive(Frame& F, const bf16* LAT, const bf16* QQ, unsigned short* IDX, int* NSEL) {
    LAS float* qi = (LAS float*)(F.lds + RING_OFF + F.wave * 16384);
    LAS unsigned* skey = (LAS unsigned*)(qi + 1024);
    LAS float* wl = (LAS float*)(skey + 2048);
    const unsigned long long ltmask = (1ull << F.lane) - 1ull;
    for (int m = F.gw; m < M; m += F.NGW) {
        const int t = m & (S - 1), b0 = m - t;
        if (t < 256) {
            for (int jj = F.lane; jj < 256; jj += 64) if (jj <= t) IDX[(size_t)m * 256 + jj] = (unsigned short)jj;
            if (F.lane == 0) NSEL[m] = t + 1;
            continue;
        }
        asm volatile("" ::: "memory");
#pragma unroll
        for (int r = 0; r < 2; ++r) { const int e = (r * 64 + F.lane) * 8; const v4u w = *(const GAS v4u*)(QQ + (size_t)m * DSA_QQ + 2048 + e); float f[8]; unpack8(w, f);
#pragma unroll
            for (int i = 0; i < 8; ++i) qi[e + i] = f[i]; }
        if (F.lane < 16) wl[F.lane] = bf2f(LAT[(size_t)m * DSA_INP + 832 + F.lane]) * (0.25f * 0.125f);
        LDS_WAIT(); asm volatile("" ::: "memory");
        const int nch = (t >> 6) + 1;
#pragma unroll 1
        for (int c = 0; c < nch; ++c) {
            asm volatile("" ::: "memory");
            const int s = c * 64 + F.lane; const bool valid = s <= t;
            const bf16* kr = LAT + (size_t)(b0 + (valid ? s : t)) * DSA_INP + 768;
            v4u kw[8];
#pragma unroll
            for (int i = 0; i < 8; ++i) kw[i] = *(const GAS v4u*)(kr + 8 * i);
            float kf[64];
#pragma unroll
            for (int i = 0; i < 8; ++i) unpack8(kw[i], kf + 8 * i);
            float sc = 0.f;
#pragma unroll 1
            for (int h = 0; h < 16; ++h) {
                float dot = 0.f;
#pragma unroll
                for (int d4 = 0; d4 < 16; ++d4) { const f32x4 q4 = *(const LAS f32x4*)(qi + h * 64 + 4 * d4); dot += (kf[4 * d4] * q4.x + kf[4 * d4 + 1] * q4.y) + (kf[4 * d4 + 2] * q4.z + kf[4 * d4 + 3] * q4.w); }
                sc += wl[h] * fmaxf(dot, 0.f);
            }
            skey[s] = valid ? f2key(sc) : 0u;
        }
        LDS_WAIT(); asm volatile("" ::: "memory");
        unsigned key[32];
#pragma unroll
        for (int c = 0; c < 32; ++c) key[c] = (c < nch) ? skey[c * 64 + F.lane] : 0u;
        unsigned T = 0u;
        for (int bit = 31; bit >= 0; --bit) {
            const unsigned cand = T | (1u << bit); int cnt = 0;
#pragma unroll
            for (int c = 0; c < 32; ++c) cnt += __popcll(__ballot(key[c] >= cand));
            if (cnt >= 256) T = cand;
        }
        int cgt = 0;
#pragma unroll
        for (int c = 0; c < 32; ++c) cgt += __popcll(__ballot(key[c] > T));
        const int need_eq = 256 - cgt;
        int base = 0, eqbase = 0;
#pragma unroll
        for (int c = 0; c < 32; ++c) {
            const bool gt = key[c] > T, eq = key[c] == T;
            const unsigned long long meq = __ballot(eq);
            const int eqrank = eqbase + __popcll(meq & ltmask);
            const bool sel = gt || (eq && eqrank < need_eq);
            const unsigned long long msel = __ballot(sel);
            const int pos = base + __popcll(msel & ltmask);
            if (sel && pos < 256) IDX[(size_t)m * 256 + pos] = (unsigned short)(c * 64 + F.lane);
            base += __popcll(msel); eqbase += __popcll(meq);
        }
        if (F.lane == 0) NSEL[m] = base < 256 ? base : 256;
    }
}

__device__ __forceinline__ void dsa_attn_naive(Frame& F, const bf16* QQ, const bf16* KV, const unsigned short* IDX, const int* NSEL, bf16* O) {
    LAS float* qs = (LAS float*)(F.lds + RING_OFF + F.wave * 16384);
    LAS float* ps = qs + 2048;
    for (int m = F.gw; m < M; m += F.NGW) {
        const int t = m & (S - 1), b0 = m - t; const int n = NSEL[m];
        asm volatile("" ::: "memory");
#pragma unroll
        for (int r = 0; r < 4; ++r) { const int e = (r * 64 + F.lane) * 8; const v4u w = *(const GAS v4u*)(QQ + (size_t)m * DSA_QQ + e); float f[8]; unpack8(w, f);
            *(LAS f32x4*)(qs + e) = (f32x4){f[0], f[1], f[2], f[3]}; *(LAS f32x4*)(qs + e + 4) = (f32x4){f[4], f[5], f[6], f[7]}; }
        LDS_WAIT(); asm volatile("" ::: "memory");
        int sidx[4];
#pragma unroll
        for (int sl = 0; sl < 4; ++sl) { const int jj = sl * 64 + F.lane; sidx[sl] = (jj < n) ? (int)IDX[(size_t)m * 256 + jj] : 0; }
#pragma unroll 1
        for (int hh = 0; hh < 2; ++hh) {
#pragma unroll 1
            for (int sl = 0; sl < 4; ++sl) {
                const int jj = sl * 64 + F.lane; const bool val = jj < n; const int sx = val ? (int)IDX[(size_t)m * 256 + jj] : 0;
                const bf16* kr = KV + (size_t)(b0 + sx) * 256;
                float kf[128];
#pragma unroll
                for (int i = 0; i < 16; ++i) { const v4u w = *(const GAS v4u*)(kr + 8 * i); unpack8(w, kf + 8 * i); }
#pragma unroll 1
                for (int h = 0; h < 8; ++h) {
                    const LAS float* qh = qs + (hh * 8 + h) * 128; float dot = 0.f;
#pragma unroll
                    for (int d4 = 0; d4 < 32; ++d4) { const f32x4 q4 = *(const LAS f32x4*)(qh + 4 * d4); dot += (kf[4 * d4] * q4.x + kf[4 * d4 + 1] * q4.y) + (kf[4 * d4 + 2] * q4.z + kf[4 * d4 + 3] * q4.w); }
                    const float slope = exp2f(-0.5f * (float)(hh * 8 + h + 1));
                    ps[jj * 8 + h] = val ? dot * 0.08838834764831845f - slope * (float)(t - sx) : -INFINITY;
                }
            }
            LDS_WAIT(); asm volatile("" ::: "memory");
            float inv_sum[8];
#pragma unroll
            for (int h = 0; h < 8; ++h) {
                float l0 = ps[(F.lane) * 8 + h], l1 = ps[(64 + F.lane) * 8 + h], l2 = ps[(128 + F.lane) * 8 + h], l3 = ps[(192 + F.lane) * 8 + h];
                const float mx = wave_max(fmaxf(fmaxf(l0, l1), fmaxf(l2, l3)));
                l0 = __expf(l0 - mx); l1 = __expf(l1 - mx); l2 = __expf(l2 - mx); l3 = __expf(l3 - mx);
                inv_sum[h] = 1.0f / wave_sum((l0 + l1) + (l2 + l3));
                ps[(F.lane) * 8 + h] = l0; ps[(64 + F.lane) * 8 + h] = l1; ps[(128 + F.lane) * 8 + h] = l2; ps[(192 + F.lane) * 8 + h] = l3;
            }
            LDS_WAIT(); asm volatile("" ::: "memory");
            float o[8][2];
#pragma unroll
            for (int h = 0; h < 8; ++h) { o[h][0] = 0.f; o[h][1] = 0.f; }
#pragma unroll
            for (int sl = 0; sl < 4; ++sl) {
                if (sl * 64 < n) {
#pragma unroll 1
                    for (int j0 = 0; j0 < 64; j0 += 4) {
                        unsigned vw[4];
#pragma unroll
                        for (int u = 0; u < 4; ++u) { const int sx = __builtin_amdgcn_readlane(sidx[sl], j0 + u); vw[u] = *(const GAS unsigned*)(KV + (size_t)(b0 + sx) * 256 + 128 + 2 * F.lane); }
#pragma unroll
                        for (int u = 0; u < 4; ++u) {
                            const float v0 = bflo(vw[u]), v1 = bfhi(vw[u]); const int jj = sl * 64 + j0 + u;
                            const f32x4 p0 = *(const LAS f32x4*)(ps + jj * 8), p1 = *(const LAS f32x4*)(ps + jj * 8 + 4);
                            o[0][0] += p0.x * v0; o[0][1] += p0.x * v1; o[1][0] += p0.y * v0; o[1][1] += p0.y * v1; o[2][0] += p0.z * v0; o[2][1] += p0.z * v1; o[3][0] += p0.w * v0; o[3][1] += p0.w * v1;
                            o[4][0] += p1.x * v0; o[4][1] += p1.x * v1; o[5][0] += p1.y * v0; o[5][1] += p1.y * v1; o[6][0] += p1.z * v0; o[6][1] += p1.z * v1; o[7][0] += p1.w * v0; o[7][1] += p1.w * v1;
                        }
                    }
                }
            }
#pragma unroll
            for (int h = 0; h < 8; ++h) *(GAS unsigned*)(O + (size_t)m * D + (hh * 8 + h) * 128 + 2 * F.lane) = pk2(o[h][0] * inv_sum[h], o[h][1] * inv_sum[h]);
            LDS_WAIT(); asm volatile("" ::: "memory");
        }
    }
}
#define GRID_BAR() xcd_barrier(bar)
struct Args { const float* in[26]; float* out; unsigned char* ws; };
template <int L>
__device__ __forceinline__ void layer_fwd(Frame& F, const Args& args, const XcdBarrier& bar) {
    unsigned char* ws = args.ws;
    const float* x_in = args.in[0];
    float* out = args.out;
    float* MOD = (float*)(ws + WS_MOD);
    bf16* H = (bf16*)(ws + WS_H);
    bf16* PROJ = (bf16*)(ws + WS_PROJ);
    bf16* OB = (bf16*)(ws + WS_O);
    bf16* HID = (bf16*)(ws + WS_BIG);
    bf16* LAT = (bf16*)(ws + WS_LAT); bf16* QL = (bf16*)(ws + WS_QL); bf16* KVL = (bf16*)(ws + WS_KVL); bf16* KV = (bf16*)(ws + WS_KV);
    unsigned short* IDX = (unsigned short*)(ws + WS_IDX); int* NSEL = (int*)(ws + WS_NSEL); bf16* QQ = (bf16*)(ws + WS_QQ);
    {
        constexpr int l = L, kind = L % 3, j = L / 3;
        const float* modl = MOD + (size_t)l * 8 * 12288;
        const float* xcur = (l == 0) ? x_in : out;
        norm_phase(F, xcur, args.in[4] + l * D, modl, 0, 2048, H);
        GRID_BAR();
        {
            const bf16* Wt = kind == 0 ? (const bf16*)(ws + WS_SWA_IN_T) + (size_t)j * SWA_IN * D : (kind == 1 ? (const bf16*)(ws + WS_DSA_IN_T) : (const bf16*)(ws + WS_DIL_IN_T));
            const int Nin = kind == 0 ? SWA_IN : (kind == 1 ? DSA_INP : DIL_IN);
            pg8::Gemm g{H, Wt, M, Nin, D}; pg8::StaticOrder So; So.init(M, Nin, F.G, (int)blockIdx.x);
            pg8::EpiBf16S<0> E{PROJ, Nin};
            pg8::gemm_phase<pg8::EpiBf16S<0>, pg8::StaticOrder, true, true>(F.lds + RING_OFF, g, So, E);
        }
        GRID_BAR();
        if constexpr (kind == 0) {
            qknorm_phase<0>(F, PROJ, SWA_IN, args.in[9] + j * 64, args.in[10] + j * 64);
            GRID_BAR();
            band_attn_naive<8, 1, true>(F, PROJ, SWA_IN, 0, 2048, 2304, OB, D, args.in[11] + j * 32, 32);
        } else if constexpr (kind == 1) {
            dsa_latnorm_phase(F, LAT, QL, KVL, args.in[14], args.in[15]);
            GRID_BAR();
            {
                pg8::Gemm g{QL, (const bf16*)(ws + WS_DSA_UQ_T), M, DSA_QQ, 512}; pg8::StaticOrder So; So.init(M, DSA_QQ, F.G, (int)blockIdx.x);
                pg8::EpiBf16S<0> E{QQ, DSA_QQ};
                pg8::gemm_phase<pg8::EpiBf16S<0>, pg8::StaticOrder, true, true>(F.lds + RING_OFF, g, So, E);
            }
            __syncthreads();
            {
                pg8::Gemm g{KVL, (const bf16*)(ws + WS_DSA_UKV_T), M, 256, 256}; pg8::StaticOrder So; So.init(M, 256, F.G, (int)blockIdx.x);
                pg8::EpiBf16S<0> E{KV, 256};
                pg8::gemm_phase<pg8::EpiBf16S<0>, pg8::StaticOrder, true, true>(F.lds + RING_OFF, g, So, E);
            }
            GRID_BAR();
            dsa_qknorm(F, QQ, KV, args.in[19], args.in[20]);
            dsa_index_naive(F, LAT, QQ, IDX, NSEL);
            GRID_BAR();
            dsa_attn_naive(F, QQ, KV, IDX, NSEL, OB);
        } else {
            qknorm_phase<2>(F, PROJ, DIL_IN, args.in[23], args.in[24]);
            GRID_BAR();
            band_attn_naive<4, 3, false>(F, PROJ, DIL_IN, 1536, 1024, 1280, OB, 1024, nullptr, 16);
        }
        GRID_BAR();
        {
            const bf16* Wt = kind == 0 ? (const bf16*)(ws + WS_SWA_OUT_T) + (size_t)j * D * D : (kind == 1 ? (const bf16*)(ws + WS_DSA_OUT_T) : (const bf16*)(ws + WS_DIL_OUT_T));
            const int Ko = kind == 2 ? 1024 : D;
            pg8::Gemm g{OB, Wt, M, D, Ko}; pg8::StaticOrder So; So.init(M, D, F.G, (int)blockIdx.x);
            pg8::EpiResGate E{xcur, out, D, modl + 4096, 12288, S};
            pg8::gemm_phase<pg8::EpiResGate, pg8::StaticOrder, true, true>(F.lds + RING_OFF, g, So, E);
        }
        GRID_BAR();
        norm_phase(F, out, args.in[5] + l * D, modl, 6144, 8192, H);
        GRID_BAR();
        {
            pg8::Gemm g{H, (const bf16*)(ws + WS_W1T) + (size_t)l * FF * D, M, FF, D}; pg8::StaticOrder So; So.init(M, FF, F.G, (int)blockIdx.x);
            pg8::EpiBf16S<1> E{HID, FF};
            pg8::gemm_phase<pg8::EpiBf16S<1>, pg8::StaticOrder, true, true>(F.lds + RING_OFF, g, So, E);
        }
        GRID_BAR();
        {
            pg8::Gemm g{HID, (const bf16*)(ws + WS_W2T) + (size_t)l * D * FF, M, D, FF}; pg8::StaticOrder So; So.init(M, D, F.G, (int)blockIdx.x);
            pg8::EpiResGate E{out, out, D, modl + 10240, 12288, S};
            pg8::gemm_phase<pg8::EpiResGate, pg8::StaticOrder, true, true>(F.lds + RING_OFF, g, So, E);
        }
        GRID_BAR();
        }
}
__global__ void __launch_bounds__(NT, 2) fwd_kernel(Args args) {
    extern __shared__ __attribute__((aligned(16))) unsigned char lds[];
    Frame F;
    F.lds = (LAS unsigned char*)lds;
    F.tid = threadIdx.x; F.lane = F.tid & 63; F.wave = __builtin_amdgcn_readfirstlane(F.tid >> 6);
    F.G = gridDim.x; F.gw = blockIdx.x * NWAVES + F.wave; F.NGW = F.G * NWAVES;
    unsigned char* ws = args.ws;
    unsigned* ctl = (unsigned*)(ws + WS_CTL);
    for (int u = F.tid; u < (LDS_BYTES - LDSCTL_OFF) / 4; u += NT) ((LAS unsigned*)(F.lds + LDSCTL_OFF))[u] = 0u;
    __syncthreads();
    XcdBarrier bar = xcd_barrier_post(ctl + CW_BAR, (volatile LAS unsigned*)(F.lds + MISC_OFF) + 8);

    float* MOD = (float*)(ws + WS_MOD);

    p0_ada(F, args.in[1], args.in[2], args.in[3], MOD);
    __syncthreads();
    p0_weights(F, args.in, ws);
    GRID_BAR();

    layer_fwd<0>(F, args, bar);
    layer_fwd<1>(F, args, bar);
    layer_fwd<2>(F, args, bar);
    layer_fwd<3>(F, args, bar);
}

extern "C" void kernel_launch(void* const* d_in, const int* in_sizes, int n_in, void* d_out, int out_size, void* d_ws, size_t ws_size, hipStream_t stream) {
    static int grid = 0;
    if (grid == 0) {
        if (n_in != 26 || in_sizes[0] != M * D || out_size != M * D || ws_size < WS_END) { fprintf(stderr, "kernel_launch: unexpected shapes / workspace (n_in %d, ws %zu)\n", n_in, ws_size); grid = -1; return; }
        int dev = 0, cus = 0, per_cu = 0;
        if (hipGetDevice(&dev) != hipSuccess || hipDeviceGetAttribute(&cus, hipDeviceAttributeMultiprocessorCount, dev) != hipSuccess) { grid = -1; return; }
        if (hipFuncSetAttribute((const void*)fwd_kernel, hipFuncAttributeMaxDynamicSharedMemorySize, LDS_BYTES) != hipSuccess) { grid = -1; return; }
        if (hipOccupancyMaxActiveBlocksPerMultiprocessor(&per_cu, (const void*)fwd_kernel, NT, LDS_BYTES) != hipSuccess || per_cu < 1) { fprintf(stderr, "kernel_launch: occupancy query reports %d\n", per_cu); }
        (void)hipGetLastError();
        grid = cus;
    }
    if (grid < 0) return;
    if (hipMemsetAsync((char*)d_ws + WS_CTL, 0, CTL_ZERO_BYTES, stream) != hipSuccess) return;
    Args a{};
    for (int i = 0; i < 26; ++i) a.in[i] = (const float*)d_in[i];
    a.out = (float*)d_out; a.ws = (unsigned char*)d_ws;
    hipLaunchKernelGGL(fwd_kernel, dim3(grid), dim3(NT), LDS_BYTES, stream, a);
}
```

```cpp
#include <hip/hip_runtime.h>
#include <cstdio>
#include <cstdint>
#include <cmath>
namespace pg8 {
#define PG8_LAS __attribute__((address_space(3)))
typedef unsigned short bf16_t;
typedef short bf16x8 __attribute__((ext_vector_type(8)));
typedef float f32x4 __attribute__((ext_vector_type(4)));
typedef unsigned u32x4 __attribute__((ext_vector_type(4)));
constexpr int BM = 256, BK = 64, HALF = 128, HTB = HALF * BK * 2  , STAGE_BYTES = 8 * HTB, NXCD = 8, WGM = 8;

__host__ __device__ __forceinline__ int lds_byte(int r, int c) { const int st = (r >> 4) * 2 + (c >> 5), rr = r & 15, cc = c & 31, ob = rr * 64 + cc * 2; return st * 1024 + (ob ^ (((ob >> 9) & 1) << 5)); }
__host__ __device__ __forceinline__ void stage_rc(int b, int& R, int& C) { const int st = b / 1024, sb = b % 1024, swz = sb ^ (((sb >> 9) & 1) << 5); R = (st >> 1) * 16 + swz / 64; C = (st & 1) * 32 + (swz % 64) / 2; }
__host__ __device__ __forceinline__ int perm32(int rho) { const int n = rho >> 4, i = rho & 15; return 8 * (i >> 2) + 4 * n + (i & 3); }

struct Unit { int pm, pn; };
struct Gemm { const bf16_t* A; const bf16_t* Bt; int M, N, K; };

struct StaticOrder {
    int nM, nN, nwg, G, c;
    __host__ __device__ void init(int M, int N, int G_, int c_) { nM = M / BM; nN = N / BM; nwg = nM * nN; G = G_; c = c_; }
    __host__ __device__ bool next(int i, Unit& u) const {
        const long L = (long)i * G + c; if (L >= nwg) return false;
        int wgid = (int)L; { const int q = nwg / NXCD, r = nwg % NXCD, xcd = wgid % NXCD, off = wgid / NXCD; wgid = (xcd < r ? xcd * (q + 1) : r * (q + 1) + (xcd - r) * q) + off; }
        const int nig = WGM * nN, gid = wgid / nig, fm = gid * WGM, gsz = (nM - fm) < WGM ? (nM - fm) : WGM;
        u.pm = fm + ((wgid % nig) % gsz); u.pn = (wgid % nig) / gsz; return true;
    }
    __device__ __forceinline__ void a_ready(const Unit&) const {}
    __device__ __forceinline__ void done(const Unit&) const {}
};
__device__ __forceinline__ unsigned cvt_pk_bf16(float lo, float hi) { unsigned r; asm volatile("v_cvt_pk_bf16_f32 %0, %1, %2" : "=v"(r) : "v"(lo), "v"(hi)); return r; }
typedef float f32x2 __attribute__((ext_vector_type(2)));
template <int ACT  > struct EpiBf16S {
    static constexpr bool PERM = true, AFTER_DRAIN = false;
    bf16_t* O; int ldc;
    __device__ __forceinline__ void operator()(const f32x4 (&acc)[2][2][4][2], const Unit& u, int wr, int wc, int fr, int fq) const {
        const int row0 = u.pm * BM + wr * 64 + fr, col0 = u.pn * BM + wc * 32 + 8 * fq;
#pragma unroll
        for (int ai = 0; ai < 2; ++ai)
#pragma unroll
            for (int m = 0; m < 4; ++m) { bf16_t* rowp = O + (size_t)(row0 + ai * HALF + m * 16) * ldc + col0;
#pragma unroll
                for (int bj = 0; bj < 2; ++bj) { f32x4 v0 = acc[ai][bj][m][0], v1 = acc[ai][bj][m][1];
                    if (ACT == 1) {
#pragma unroll
                        for (int e = 0; e < 4; ++e) { const float a = fmaxf(v0[e], 0.f), b = fmaxf(v1[e], 0.f); v0[e] = a * a; v1[e] = b * b; } }
                    u32x4 w; w.x = cvt_pk_bf16(v0[0], v0[1]); w.y = cvt_pk_bf16(v0[2], v0[3]); w.z = cvt_pk_bf16(v1[0], v1[1]); w.w = cvt_pk_bf16(v1[2], v1[3]);
                    *(u32x4*)(rowp + bj * HALF) = w; } }
    }
};
struct EpiResGate {
    static constexpr bool PERM = false, AFTER_DRAIN = false;
    const float* base; float* out; int ldc; const float* gate; int gate_bstride; int rows_per_batch;
    __device__ __forceinline__ void operator()(const f32x4 (&acc)[2][2][4][2], const Unit& u, int wr, int wc, int fr, int fq) const {
        const int row0 = u.pm * BM + wr * 64 + fr, col0 = u.pn * BM + wc * 32 + 4 * fq;
        const float* gp = gate + (size_t)((u.pm * BM) / rows_per_batch) * gate_bstride + col0;
        f32x4 gv[2][2];
#pragma unroll
        for (int bj = 0; bj < 2; ++bj)
#pragma unroll
            for (int n = 0; n < 2; ++n) gv[bj][n] = *(const f32x4*)(gp + bj * HALF + n * 16);
#pragma unroll
        for (int ai = 0; ai < 2; ++ai)
#pragma unroll
            for (int m = 0; m < 4; ++m) { const size_t off = (size_t)(row0 + ai * HALF + m * 16) * ldc + col0;
#pragma unroll
                for (int bj = 0; bj < 2; ++bj)
#pragma unroll
                    for (int n = 0; n < 2; ++n) { const f32x4 bs = *(const f32x4*)(base + off + bj * HALF + n * 16); *(f32x4*)(out + off + bj * HALF + n * 16) = bs + gv[bj][n] * acc[ai][bj][m][n]; } }
    }
};
struct EpiQKV {
    static constexpr bool PERM = true, AFTER_DRAIN = false;
    bf16_t* O; int ldc; bf16_t* VT; int vmod, vres; int S_;
    __device__ __forceinline__ void operator()(const f32x4 (&acc)[2][2][4][2], const Unit& u, int wr, int wc, int fr, int fq) const {
        const int row0 = u.pm * BM + wr * 64 + fr;
        if (u.pn % vmod == vres) {
            const int gi = u.pn / vmod, dsh = 2 * gi, b = (u.pm * BM) / S_;
            bf16_t* vb = VT + ((size_t)gi * 8 + b) * 4 * 64 * S_;
            const unsigned lane_off = (unsigned)((wc * 32 + 8 * fq) * S_);
#pragma unroll
            for (int ai = 0; ai < 2; ++ai)
#pragma unroll
                for (int m = 0; m < 4; ++m) { const int t = (row0 + ai * HALF + m * 16) & (S_ - 1); const unsigned voff = lane_off + (unsigned)((t & ((1 << dsh) - 1)) * (S_ >> dsh) + (t >> dsh));
#pragma unroll
                    for (int bj = 0; bj < 2; ++bj)
#pragma unroll
                        for (int n = 0; n < 2; ++n)
#pragma unroll
                            for (int e = 0; e < 4; ++e) { bf16_t* vu = vb + (size_t)(bj * HALF + 4 * n + e) * S_;
                                const unsigned w = cvt_pk_bf16(acc[ai][bj][m][n][e], 0.f); vu[voff] = (bf16_t)(w & 0xffffu); }
                    asm volatile("" ::: "memory"); }
            return;
        }
        const int col0 = u.pn * BM + wc * 32 + 8 * fq;
#pragma unroll
        for (int ai = 0; ai < 2; ++ai)
#pragma unroll
            for (int m = 0; m < 4; ++m) { bf16_t* rowp = O + (size_t)(row0 + ai * HALF + m * 16) * ldc + col0;
#pragma unroll
                for (int bj = 0; bj < 2; ++bj) { const f32x4 v0 = acc[ai][bj][m][0], v1 = acc[ai][bj][m][1];
                    u32x4 w; w.x = cvt_pk_bf16(v0[0], v0[1]); w.y = cvt_pk_bf16(v0[2], v0[3]); w.z = cvt_pk_bf16(v1[0], v1[1]); w.w = cvt_pk_bf16(v1[2], v1[3]);
                    *(u32x4*)(rowp + bj * HALF) = w; } }
    }
};
struct EpiKVd {
    static constexpr bool PERM = true, AFTER_DRAIN = false;
    bf16_t* O; int ldc; bf16_t* VT; int S_;
    __device__ __forceinline__ void operator()(const f32x4 (&acc)[2][2][4][2], const Unit& u, int wr, int wc, int fr, int fq) const {
        const int row0 = u.pm * BM + wr * 64 + fr, col0 = u.pn * BM + wc * 32 + 8 * fq;
#pragma unroll
        for (int ai = 0; ai < 2; ++ai)
#pragma unroll
            for (int m = 0; m < 4; ++m) { const int r = row0 + ai * HALF + m * 16;
                const f32x4 v0 = acc[ai][0][m][0], v1 = acc[ai][0][m][1];
                u32x4 w; w.x = cvt_pk_bf16(v0[0], v0[1]); w.y = cvt_pk_bf16(v0[2], v0[3]); w.z = cvt_pk_bf16(v1[0], v1[1]); w.w = cvt_pk_bf16(v1[2], v1[3]);
                *(u32x4*)(O + (size_t)r * ldc + col0) = w; }
        asm volatile("" ::: "memory");
        const int b = (u.pm * BM) / S_;
        bf16_t* vb = VT + (size_t)b * 128 * S_;
        const unsigned lane_off = (unsigned)((wc * 32 + 8 * fq) * S_ + (row0 & (S_ - 1)));
#pragma unroll
        for (int ai = 0; ai < 2; ++ai)
#pragma unroll
            for (int m = 0; m < 4; ++m) {
#pragma unroll
                for (int n = 0; n < 2; ++n)
#pragma unroll
                    for (int e = 0; e < 4; ++e) { bf16_t* vu = vb + (size_t)(4 * n + e) * S_ + ai * HALF + m * 16; const unsigned w = cvt_pk_bf16(acc[ai][1][m][n][e], 0.f); vu[lane_off] = (bf16_t)(w & 0xffffu); }
                asm volatile("" ::: "memory"); }
    }
};
template <class Epi, class Sched, bool ALIGN_EPI = false, bool SP2 = false>
__device__ __forceinline__ void gemm_phase(PG8_LAS unsigned char* lds, const Gemm g, const Sched& S, const Epi& E) {
    int tid_ = threadIdx.x; asm volatile("" : "+v"(tid_));
    const int tid = tid_, wid = __builtin_amdgcn_readfirstlane(tid >> 6), lane = tid & 63, wr = wid >> 2, wc = wid & 3, fr = lane & 15, fq = lane >> 4;
    const int K = g.K, nt = K / BK;
    unsigned voffA[2], voffB[2];
#pragma unroll
    for (int i = 0; i < 2; ++i) { int R, C; stage_rc(tid * 16 + i * 8192, R, C); const int Rb = Epi::PERM ? ((R & ~31) + perm32(R & 31)) : R;
        voffA[i] = (unsigned)(R * K + C) * 2u; voffB[i] = (unsigned)(Rb * K + C) * 2u; }
    const size_t kstep = (size_t)(BK * 2);
    const size_t hstep = (size_t)HALF * K * 2;
    const size_t tstep = 2 * hstep;
    const unsigned ldsw = (unsigned)wid * 1024u;
    const int aoff = lds_byte(wr * 64 + fr, fq * 8), boff = lds_byte(wc * 32 + fr, fq * 8);
#define PG8_SA(b, h) (((b) * 2 + (h)) * HTB)
#define PG8_SB(b, h) ((4 + (b) * 2 + (h)) * HTB)
#define PG8_STAGE(bufoff, gbase, voff) do { _Pragma("unroll") for (int _i = 0; _i < 2; ++_i) \
        __builtin_amdgcn_global_load_lds((const unsigned*)((const char*)(gbase) + (voff)[_i]), (PG8_LAS unsigned*)(lds + (bufoff) + ldsw + _i * 8192), 16, 0, 0); } while (0)
#define PG8_LDA(dst, b, h) do { _Pragma("unroll") for (int m = 0; m < 4; ++m) _Pragma("unroll") for (int k = 0; k < 2; ++k) dst[m][k] = *(const PG8_LAS bf16x8*)(lds + PG8_SA(b, h) + aoff + m * 2048 + k * 1024); } while (0)
#define PG8_LDB(dst, b, h) do { _Pragma("unroll") for (int n = 0; n < 2; ++n) _Pragma("unroll") for (int k = 0; k < 2; ++k) dst[n][k] = *(const PG8_LAS bf16x8*)(lds + PG8_SB(b, h) + boff + n * 2048 + k * 1024); } while (0)
#define PG8_MMA(ai, bj, At, Bt) do { __builtin_amdgcn_s_setprio(1); _Pragma("unroll") for (int m = 0; m < 4; ++m) _Pragma("unroll") for (int n = 0; n < 2; ++n) _Pragma("unroll") for (int k = 0; k < 2; ++k) \
        acc[ai][bj][m][n] = __builtin_amdgcn_mfma_f32_16x16x32_bf16(Bt[n][k], At[m][k], acc[ai][bj][m][n], 0, 0, 0); __builtin_amdgcn_s_setprio(0); } while (0)
#define PG8_WAIT_V(n) asm volatile("s_waitcnt vmcnt(" #n ")" ::: "memory")
#define PG8_WAIT_L(n) asm volatile("s_waitcnt lgkmcnt(" #n ")" ::: "memory")
#define PG8_BAR __builtin_amdgcn_s_barrier()
#define PG8_SCHED __builtin_amdgcn_sched_barrier(0)
    Unit cur, nxt; int ui = 0;
    if (!S.next(0, cur)) return;
    f32x4 acc[2][2][4][2];
#pragma unroll
    for (int a = 0; a < 2; ++a)
#pragma unroll
        for (int b = 0; b < 2; ++b)
#pragma unroll
            for (int m = 0; m < 4; ++m)
#pragma unroll
                for (int n = 0; n < 2; ++n) acc[a][b][m][n] = (f32x4){0.f, 0.f, 0.f, 0.f};
    bf16x8 At[4][2], B0[2][2], B1[2][2];
    const char* cA = (const char*)g.A + (size_t)cur.pm * tstep; const char* cB = (const char*)g.Bt + (size_t)cur.pn * tstep;
    S.a_ready(cur);
    if constexpr (SP2) {
        PG8_STAGE(PG8_SB(0, 0), cB, voffB); PG8_STAGE(PG8_SB(0, 1), cB + hstep, voffB); PG8_STAGE(PG8_SA(0, 0), cA, voffA); PG8_STAGE(PG8_SA(0, 1), cA + hstep, voffA);
        if (wr == 1) PG8_BAR;
        PG8_WAIT_V(2); PG8_BAR;
        PG8_STAGE(PG8_SB(1, 0), cB + kstep, voffB); PG8_STAGE(PG8_SA(1, 0), cA + kstep, voffA); PG8_STAGE(PG8_SB(1, 1), cB + hstep + kstep, voffB);
        PG8_WAIT_V(6); PG8_BAR;
    } else {
        PG8_STAGE(PG8_SB(0, 0), cB, voffB); PG8_STAGE(PG8_SA(0, 0), cA, voffA); PG8_STAGE(PG8_SB(0, 1), cB + hstep, voffB); PG8_STAGE(PG8_SA(0, 1), cA + hstep, voffA);
        if (wr == 1) PG8_BAR;
        PG8_WAIT_V(4); PG8_BAR;
        PG8_STAGE(PG8_SB(1, 0), cB + kstep, voffB); PG8_STAGE(PG8_SA(1, 0), cA + kstep, voffA); PG8_STAGE(PG8_SB(1, 1), cB + hstep + kstep, voffB);
        PG8_WAIT_V(6); PG8_BAR;
    }
    for (;;) {
        const bool has_next = S.next(ui + 1, nxt);
        const char* nA = has_next ? (const char*)g.A + (size_t)nxt.pm * tstep : cA; const char* nB = has_next ? (const char*)g.Bt + (size_t)nxt.pn * tstep : cB;
#pragma unroll 1
        for (int t = 0; t < nt; t += 2) {
            const bool last = (t == nt - 2);
            const char* a1 = cA + (size_t)(t + 1) * kstep;
            const char* a2 = last ? nA : cA + (size_t)(t + 2) * kstep; const char* b2 = last ? nB : cB + (size_t)(t + 2) * kstep;
            const char* a3 = a2 + kstep; const char* b3 = b2 + kstep;
            if (last && has_next) S.a_ready(nxt);
            if constexpr (SP2) {
            PG8_LDB(B0, 0, 0); PG8_LDB(B1, 0, 1); PG8_SCHED; PG8_LDA(At, 0, 0); PG8_STAGE(PG8_SA(1, 1), a1 + hstep, voffA);
            PG8_WAIT_V(8); PG8_WAIT_L(0); PG8_BAR; PG8_MMA(0, 0, At, B0); PG8_MMA(0, 1, At, B1); PG8_BAR; PG8_SCHED;
            PG8_LDA(At, 0, 1); PG8_STAGE(PG8_SB(0, 0), b2, voffB); PG8_STAGE(PG8_SB(0, 1), b2 + hstep, voffB); PG8_STAGE(PG8_SA(0, 0), a2, voffA);
            PG8_WAIT_V(8); PG8_WAIT_L(0); PG8_BAR; PG8_MMA(1, 0, At, B0); PG8_MMA(1, 1, At, B1); PG8_BAR; PG8_SCHED;
            PG8_LDB(B0, 1, 0); PG8_LDB(B1, 1, 1); PG8_SCHED; PG8_LDA(At, 1, 0); PG8_STAGE(PG8_SA(0, 1), a2 + hstep, voffA);
            PG8_WAIT_V(8); PG8_WAIT_L(0); PG8_BAR; PG8_MMA(0, 0, At, B0); PG8_MMA(0, 1, At, B1); PG8_BAR; PG8_SCHED;
            PG8_LDA(At, 1, 1); PG8_STAGE(PG8_SB(1, 0), b3, voffB); PG8_STAGE(PG8_SB(1, 1), b3 + hstep, voffB); PG8_STAGE(PG8_SA(1, 0), a3, voffA);
            PG8_WAIT_V(8); PG8_WAIT_L(0); PG8_BAR; PG8_MMA(1, 0, At, B0); PG8_MMA(1, 1, At, B1); PG8_BAR; PG8_SCHED;
            } else {
            PG8_LDB(B0, 0, 0); PG8_SCHED; PG8_LDA(At, 0, 0); PG8_STAGE(PG8_SA(1, 1), a1 + hstep, voffA);
            PG8_WAIT_L(8); PG8_BAR; PG8_WAIT_L(0); PG8_MMA(0, 0, At, B0); PG8_BAR; PG8_SCHED;
            PG8_LDB(B1, 0, 1); PG8_STAGE(PG8_SB(0, 0), b2, voffB);
            PG8_BAR; PG8_WAIT_L(0); PG8_MMA(0, 1, At, B1); PG8_BAR;
            PG8_LDA(At, 0, 1); PG8_STAGE(PG8_SA(0, 0), a2, voffA);
            PG8_BAR; PG8_WAIT_L(0); PG8_MMA(1, 0, At, B0); PG8_BAR; PG8_SCHED;
            PG8_STAGE(PG8_SB(0, 1), b2 + hstep, voffB);
            PG8_WAIT_V(6); PG8_BAR; PG8_MMA(1, 1, At, B1); PG8_BAR;
            PG8_LDB(B0, 1, 0); PG8_SCHED; PG8_LDA(At, 1, 0); PG8_STAGE(PG8_SA(0, 1), a2 + hstep, voffA);
            PG8_WAIT_L(8); PG8_BAR; PG8_WAIT_L(0); PG8_MMA(0, 0, At, B0); PG8_BAR; PG8_SCHED;
            PG8_LDB(B1, 1, 1); PG8_STAGE(PG8_SB(1, 0), b3, voffB);
            PG8_BAR; PG8_WAIT_L(0); PG8_MMA(0, 1, At, B1); PG8_BAR;
            PG8_LDA(At, 1, 1); PG8_STAGE(PG8_SA(1, 0), a3, voffA);
            PG8_BAR; PG8_WAIT_L(0); PG8_MMA(1, 0, At, B0); PG8_BAR; PG8_SCHED;
            PG8_STAGE(PG8_SB(1, 1), b3 + hstep, voffB);
            PG8_WAIT_V(6); PG8_BAR; PG8_MMA(1, 1, At, B1); PG8_BAR;
            }
        }
        if constexpr (ALIGN_EPI) { if (wr == 0) PG8_BAR; }
        if constexpr (!Epi::AFTER_DRAIN) { E(acc, cur, wr, wc, fr, fq); S.done(cur); }
        if (!has_next) break;
#pragma unroll
        for (int a = 0; a < 2; ++a)
#pragma unroll
            for (int b = 0; b < 2; ++b)
#pragma unroll
                for (int m = 0; m < 4; ++m)
#pragma unroll
                    for (int n = 0; n < 2; ++n) acc[a][b][m][n] = (f32x4){0.f, 0.f, 0.f, 0.f};
        cur = nxt; cA = nA; cB = nB; ++ui;
        if constexpr (ALIGN_EPI) { if (wr == 1) PG8_BAR; }
    }
    PG8_WAIT_V(0);
    if constexpr (!ALIGN_EPI) { if (wr == 0) PG8_BAR; }
    PG8_BAR;
    if constexpr (Epi::AFTER_DRAIN) { E.fused(acc, cur, wr, wc, fr, fq, lds, wid, lane); S.done(cur); }
#undef PG8_SA
#undef PG8_SB
#undef PG8_STAGE
#undef PG8_LDA
#undef PG8_LDB
#undef PG8_MMA
#undef PG8_WAIT_V
#undef PG8_WAIT_L
#undef PG8_BAR
#undef PG8_SCHED
}
}
constexpr int NWAVES = 8, NT = NWAVES * 64;
constexpr int BATCH = 8, S = 2048, D = 2048, M = BATCH * S, FF = 8192, DEPTH = 4;
constexpr int SWA_IN = 2560, DSA_INP = 1024  , DSA_IN_SRC = 848, DIL_IN = 4608, DSA_QQ = 3072;
constexpr float EPS = 1e-6f;
constexpr size_t MiB = 1u << 20;
constexpr size_t WS_CTL = 0, CTL_ZERO_BYTES = 1 * MiB;
constexpr size_t WS_MOD = 1 * MiB;
constexpr size_t WS_W1T = 4 * MiB, WS_W2T = 132 * MiB;
constexpr size_t WS_SWA_IN_T = 260 * MiB, WS_SWA_OUT_T = 280 * MiB;
constexpr size_t WS_DSA_IN_T = 296 * MiB, WS_DSA_UQ_T = 300 * MiB, WS_DSA_UKV_T = 303 * MiB, WS_DSA_OUT_T = 304 * MiB;
constexpr size_t WS_DIL_IN_T = 312 * MiB, WS_DIL_OUT_T = 330 * MiB;
constexpr size_t WS_H = 334 * MiB;
constexpr size_t WS_BIG = 398 * MiB;
constexpr size_t WS_PROJ = WS_BIG;
constexpr size_t WS_O = WS_BIG + 192 * MiB;
constexpr size_t WS_LAT = WS_BIG, WS_QL = WS_BIG + 32 * MiB, WS_KVL = WS_BIG + 48 * MiB, WS_KV = WS_BIG + 56 * MiB, WS_IDX = WS_BIG + 64 * MiB, WS_NSEL = WS_BIG + 72 * MiB, WS_QQ = WS_BIG + 80 * MiB;
constexpr size_t WS_VT = WS_BIG + 144 * MiB, WS_LSE = WS_BIG + 170 * MiB;
constexpr size_t WS_VTD = WS_BIG + 64 * MiB;
constexpr size_t WS_END = 654 * MiB;
constexpr int CW_BAR = 4096;
constexpr int RING_OFF = 0, RING_BYTES = 131072;
constexpr int LDSCTL_OFF = RING_BYTES, MISC_OFF = LDSCTL_OFF + 320;
constexpr int LDS_BYTES = 147456;

#define GAS __attribute__((address_space(1)))
#define LAS __attribute__((address_space(3)))
typedef unsigned short bf16;
typedef unsigned v4u __attribute__((ext_vector_type(4)));
typedef unsigned v2u __attribute__((ext_vector_type(2)));
typedef float f32x4 __attribute__((ext_vector_type(4)));
#define LDS_WAIT() asm volatile("s_waitcnt lgkmcnt(0)" ::: "memory")
#define VM_WAIT() asm volatile("s_waitcnt vmcnt(0)" ::: "memory")
__device__ __forceinline__ unsigned f2bf(float f) { unsigned u = __builtin_bit_cast(unsigned, f); return (u + 0x7fffu + ((u >> 16) & 1u)) >> 16; }
__device__ __forceinline__ unsigned pk2(float lo, float hi) { return f2bf(lo) | (f2bf(hi) << 16); }
__device__ __forceinline__ float bflo(unsigned w) { return __uint_as_float(w << 16); }
__device__ __forceinline__ float bfhi(unsigned w) { return __uint_as_float(w & 0xffff0000u); }
__device__ __forceinline__ float bf2f(bf16 v) { return __uint_as_float((unsigned)v << 16); }
__device__ __forceinline__ void unpack8(const v4u w, float* f) { f[0] = bflo(w.x); f[1] = bfhi(w.x); f[2] = bflo(w.y); f[3] = bfhi(w.y); f[4] = bflo(w.z); f[5] = bfhi(w.z); f[6] = bflo(w.w); f[7] = bfhi(w.w); }
__device__ __forceinline__ float wave_sum(float v) {
#pragma unroll
    for (int o = 1; o < 64; o <<= 1) v += __shfl_xor(v, o);
    return v;
}
__device__ __forceinline__ float wave_max(float v) {
#pragma unroll
    for (int o = 1; o < 64; o <<= 1) v = fmaxf(v, __shfl_xor(v, o));
    return v;
}
#define XB_TMO      128
#define XB_XCNT(j)  (256  + 64 * (j))
#define XB_XSUB(j)  (1280 + 64 * (j))
#define XB_XGEN(j)  (2304 + 64 * (j))
#define XB_TOP      3328
#define XB_TOPGEN   3392
#define XCD_BAR_WORDS 3456
#define XB_SPIN_CAP (1u << 18)

__device__ __forceinline__ unsigned xb_ld(unsigned* p)              { return __hip_atomic_load(p, __ATOMIC_RELAXED, __HIP_MEMORY_SCOPE_AGENT); }
__device__ __forceinline__ unsigned xb_add(unsigned* p, unsigned v) { return __hip_atomic_fetch_add(p, v, __ATOMIC_RELAXED, __HIP_MEMORY_SCOPE_AGENT); }
__device__ __forceinline__ unsigned xb_xcc_id() { return (unsigned)__builtin_amdgcn_s_getreg((3 << 11) | 20) & 0xFu; }
#define XB_SPIN(cond, bar) do { unsigned _sp = 0; while (cond) { __builtin_amdgcn_s_sleep(1); \
    if ((++_sp & 255u) == 0u) { if (xb_ld(&(bar)[XB_TMO])) break; if (_sp > XB_SPIN_CAP) { atomicAdd(&(bar)[XB_TMO], 1u); break; } } } } while (0)

struct XcdBarrier {
    unsigned* bar; unsigned x;
    volatile LAS unsigned* st;
};

__device__ __forceinline__ XcdBarrier xcd_barrier_post(unsigned* bar, volatile LAS unsigned* st) {
    XcdBarrier b; b.bar = bar; b.x = xb_xcc_id(); b.st = st;
    if (threadIdx.x == 0) (void)xb_add(&bar[XB_XCNT(b.x)], 1u);
    return b;
}
__device__ __forceinline__ void xcd_barrier_complete(unsigned* bar, unsigned x, unsigned& nloc, unsigned& nx) {
    const unsigned G = gridDim.x * gridDim.y * gridDim.z;
    unsigned sum, cnt, mine, sp = 0u;
    for (;;) {
        sum = 0u; cnt = 0u; mine = 0u;
#pragma unroll
        for (unsigned j = 0; j < 16; ++j) { const unsigned c = xb_ld(&bar[XB_XCNT(j)]); sum += c; cnt += (c > 0u) ? 1u : 0u; mine = (j == x) ? c : mine; }
        if (sum == G) break;
        __builtin_amdgcn_s_sleep(1);
        if ((++sp & 255u) == 0u) { if (xb_ld(&bar[XB_TMO])) break; if (sp > XB_SPIN_CAP) { atomicAdd(&bar[XB_TMO], 1u); break; } }
    }
    nloc = mine > 0u ? mine : 1u; nx = cnt > 0u ? cnt : 1u;
}

__device__ __forceinline__ void xcd_barrier(const XcdBarrier& b) {
    asm volatile("s_waitcnt vmcnt(0)" ::: "memory");
    __syncthreads();
    if (threadIdx.x == 0) {
        unsigned* bar = b.bar;
        __builtin_amdgcn_s_waitcnt(0);
        unsigned nloc = b.st[0], nx = b.st[1];
        if (nloc == 0u) { xcd_barrier_complete(bar, b.x, nloc, nx); b.st[0] = nloc; b.st[1] = nx; }
        const unsigned old = xb_add(&bar[XB_XSUB(b.x)], 1u);
        const unsigned gen = old / nloc;
        if (old + 1u == (gen + 1u) * nloc) {
            __builtin_amdgcn_fence(__ATOMIC_RELEASE, "agent");
            asm volatile("s_waitcnt vmcnt(0)" ::: "memory");
            const unsigned og = xb_add(&bar[XB_TOP], 1u);
            const unsigned tg = og / nx;
            if (og + 1u == (tg + 1u) * nx) xb_add(&bar[XB_TOPGEN], 1u);
            else XB_SPIN(xb_ld(&bar[XB_TOPGEN]) == tg, bar);
            __builtin_amdgcn_fence(__ATOMIC_ACQUIRE, "agent");
            xb_add(&bar[XB_XGEN(b.x)], 1u);
            asm volatile("s_waitcnt vmcnt(0)" ::: "memory");
        } else {
            XB_SPIN(xb_ld(&bar[XB_XGEN(b.x)]) == gen, bar);
            __builtin_amdgcn_fence(__ATOMIC_ACQUIRE, "agent");
            asm volatile("s_waitcnt vmcnt(0)" ::: "memory");
        }
    }
    __syncthreads();
}
struct Frame {
    LAS unsigned char* lds;
    int tid, lane, wave, G, gw, NGW;
};

__device__ __forceinline__ void p0_ada(Frame& F, const float* c, const float* ada_w, const float* ada_b, float* mod) {
    LAS float* cond = (LAS float*)(F.lds + RING_OFF);
    LAS float* red = (LAS float*)(F.lds + RING_OFF + 65536);
    for (int i = F.tid; i < 8 * 2048; i += NT) { const int b = i >> 11, k = i & 2047; const float v = c[i]; cond[k * 8 + b] = v / (1.f + __expf(-v)); }
    __syncthreads();
    constexpr int NSLAB = DEPTH * 64;
    for (int slab = blockIdx.x; slab < NSLAB; slab += F.G) {
        const int layer = slab >> 6, col0 = (slab & 63) * 192;
        const float* W = ada_w + (size_t)layer * 2048 * 12288 + col0 + F.lane;
        float acc[3][8];
#pragma unroll
        for (int j = 0; j < 3; ++j)
#pragma unroll
            for (int b = 0; b < 8; ++b) acc[j][b] = 0.f;
        const int k0 = F.wave * 256;
        for (int k = k0; k < k0 + 256; k += 8) {
            float w[8][3];
#pragma unroll
            for (int kk = 0; kk < 8; ++kk)
#pragma unroll
                for (int j = 0; j < 3; ++j) w[kk][j] = W[(size_t)(k + kk) * 12288 + 64 * j];
#pragma unroll
            for (int kk = 0; kk < 8; ++kk) {
                const f32x4 c0 = *(const LAS f32x4*)(cond + (k + kk) * 8), c1 = *(const LAS f32x4*)(cond + (k + kk) * 8 + 4);
#pragma unroll
                for (int j = 0; j < 3; ++j) {
                    acc[j][0] += w[kk][j] * c0[0]; acc[j][1] += w[kk][j] * c0[1]; acc[j][2] += w[kk][j] * c0[2]; acc[j][3] += w[kk][j] * c0[3];
                    acc[j][4] += w[kk][j] * c1[0]; acc[j][5] += w[kk][j] * c1[1]; acc[j][6] += w[kk][j] * c1[2]; acc[j][7] += w[kk][j] * c1[3]; }
            }
        }
#pragma unroll
        for (int j = 0; j < 3; ++j)
#pragma unroll
            for (int b = 0; b < 8; ++b) red[(F.wave * 8 + b) * 192 + j * 64 + F.lane] = acc[j][b];
        __syncthreads();
        for (int o = F.tid; o < 8 * 192; o += NT) { const int b = o / 192, cc = o % 192; float s = 0.f;
#pragma unroll
            for (int w = 0; w < 8; ++w) s += red[(w * 8 + b) * 192 + cc];
            mod[(size_t)(layer * 8 + b) * 12288 + col0 + cc] = s + ada_b[layer * 12288 + col0 + cc]; }
        __syncthreads();
    }
}

__device__ __forceinline__ void p0_transpose_item(const float* W, int K, int Nsrc, int Npad, bf16* WT, int row_off, LAS float* scr, int item, int lane) {
    const int nblk = Npad / 32, kb = item / nblk, nb = item % nblk, k0 = 64 * kb, n0 = 32 * nb;
    const int nc = n0 + (lane & 31); const bool ok = nc < Nsrc;
#pragma unroll 8
    for (int i = 0; i < 32; ++i) { const int kk = 2 * i + (lane >> 5); scr[kk * 33 + (lane & 31)] = ok ? W[(size_t)(k0 + kk) * Nsrc + nc] : 0.f; }
    LDS_WAIT(); asm volatile("" ::: "memory");
    const int cch = lane & 7;
#pragma unroll
    for (int j = 0; j < 4; ++j) { const int n = (lane >> 3) + 8 * j; const LAS float* s = scr + (8 * cch) * 33 + n;
        v4u o; o.x = pk2(s[0 * 33], s[1 * 33]); o.y = pk2(s[2 * 33], s[3 * 33]); o.z = pk2(s[4 * 33], s[5 * 33]); o.w = pk2(s[6 * 33], s[7 * 33]);
        *(GAS v4u*)(WT + (size_t)(row_off + n0 + n) * K + k0 + 8 * cch) = o; }
    LDS_WAIT(); asm volatile("" ::: "memory");
}
struct TJob { const float* src; bf16* dst; int K, Nsrc, Npad, row_off, items; };
__device__ __forceinline__ void p0_weights(Frame& F, const float* const* in, unsigned char* ws) {
    LAS float* scr = (LAS float*)(F.lds + RING_OFF + F.wave * 16384);
    constexpr int NJOB = 19;
    for (int it = F.gw; ; it += F.NGW) {
        int r = it; TJob jb; bool found = false;
#pragma unroll
        for (int q = 0; q < NJOB; ++q) {
            TJob t;
            if (q < 4)       t = TJob{in[6] + (size_t)q * D * FF, (bf16*)(ws + WS_W1T) + (size_t)q * FF * D, D, FF, FF, 0, (D / 64) * (FF / 32)};
            else if (q < 8)  t = TJob{in[7] + (size_t)(q - 4) * FF * D, (bf16*)(ws + WS_W2T) + (size_t)(q - 4) * D * FF, FF, D, D, 0, (FF / 64) * (D / 32)};
            else if (q < 10) t = TJob{in[8] + (size_t)(q - 8) * D * SWA_IN, (bf16*)(ws + WS_SWA_IN_T) + (size_t)(q - 8) * SWA_IN * D, D, SWA_IN, SWA_IN, 0, (D / 64) * (SWA_IN / 32)};
            else if (q < 12) t = TJob{in[12] + (size_t)(q - 10) * D * D, (bf16*)(ws + WS_SWA_OUT_T) + (size_t)(q - 10) * D * D, D, D, D, 0, (D / 64) * (D / 32)};
            else if (q == 12) t = TJob{in[13], (bf16*)(ws + WS_DSA_IN_T), D, DSA_IN_SRC, DSA_INP, 0, (D / 64) * (DSA_INP / 32)};
            else if (q == 13) t = TJob{in[16], (bf16*)(ws + WS_DSA_UQ_T), 512, 2048, 2048, 0, (512 / 64) * (2048 / 32)};
            else if (q == 14) t = TJob{in[18], (bf16*)(ws + WS_DSA_UQ_T), 512, 1024, 1024, 2048, (512 / 64) * (1024 / 32)};
            else if (q == 15) t = TJob{in[17], (bf16*)(ws + WS_DSA_UKV_T), 256, 256, 256, 0, (256 / 64) * (256 / 32)};
            else if (q == 16) t = TJob{in[21], (bf16*)(ws + WS_DSA_OUT_T), D, D, D, 0, (D / 64) * (D / 32)};
            else if (q == 17) t = TJob{in[22], (bf16*)(ws + WS_DIL_IN_T), D, DIL_IN, DIL_IN, 0, (D / 64) * (DIL_IN / 32)};
            else              t = TJob{in[25], (bf16*)(ws + WS_DIL_OUT_T), 1024, D, D, 0, (1024 / 64) * (D / 32)};
            if (!found) { if (r < t.items) { jb = t; found = true; } else r -= t.items; }
        }
        if (!found) break;
        p0_transpose_item(jb.src, jb.K, jb.Nsrc, jb.Npad, jb.dst, jb.row_off, scr, r, F.lane);
    }
}

__device__ __forceinline__ void norm_phase(Frame& F, const float* x, const float* gain, const float* modl, int sh_off, int sc_off, bf16* H) {
    for (int rg = F.gw; rg < M / 8; rg += F.NGW) {
        const int m0 = rg * 8, b = m0 / S;
        const float* mb = modl + (size_t)b * 12288;
        f32x4 A[8], Sh[8];
#pragma unroll
        for (int j = 0; j < 8; ++j) { const int col = 4 * (F.lane + 64 * j); const f32x4 g = *(const f32x4*)(gain + col), sc = *(const f32x4*)(mb + sc_off + col); Sh[j] = *(const f32x4*)(mb + sh_off + col); A[j] = g * (sc + 1.0f); }
        for (int r = 0; r < 8; ++r) {
            const GAS f32x4* xr = (const GAS f32x4*)(x + (size_t)(m0 + r) * D) + F.lane;
            f32x4 v[8]; float ss = 0.f;
#pragma unroll
            for (int j = 0; j < 8; ++j) { v[j] = xr[64 * j]; ss += (v[j].x * v[j].x + v[j].y * v[j].y) + (v[j].z * v[j].z + v[j].w * v[j].w); }
            const float rstd = 1.0f / sqrtf(wave_sum(ss) * (1.f / D) + EPS);
            GAS v2u* o8 = (GAS v2u*)(H + (size_t)(m0 + r) * D) + F.lane;
#pragma unroll
            for (int j = 0; j < 8; ++j) { const f32x4 h = v[j] * rstd * A[j] + Sh[j]; v2u w; w.x = pk2(h.x, h.y); w.y = pk2(h.z, h.w); o8[64 * j] = w; }
        }
    }
}

template <int KIND>
__device__ __forceinline__ void qknorm_phase(Frame& F, bf16* P, int pitch, const float* qn, const float* kn) {
    constexpr int NCOLS = KIND == 0 ? 2304 : DIL_IN;
    for (int m = F.gw; m < M; m += F.NGW) {
        bf16* row = P + (size_t)m * pitch;
        for (int c0 = 0; c0 < NCOLS; c0 += 512) {
            const int col = c0 + 8 * F.lane;
            bool act; const float* g;
            if (KIND == 0) { act = col < 2304; g = (col < 2048 ? qn : kn) + (col & 63); }
            else { const int gi = col / 1536, cl = col - gi * 1536; act = cl < 1280; g = (cl < 1024 ? qn : kn) + gi * 64 + (col & 63); }
            float f[8]; float ss = 0.f;
            if (act) { const v4u w = *(const GAS v4u*)(row + col); unpack8(w, f);
#pragma unroll
                for (int e = 0; e < 8; ++e) ss += f[e] * f[e]; }
            ss += __shfl_xor(ss, 1); ss += __shfl_xor(ss, 2); ss += __shfl_xor(ss, 4);
            if (act) { const float rstd = 1.0f / sqrtf(ss * (1.f / 64.f) + EPS); const f32x4 g0 = *(const f32x4*)g, g1 = *(const f32x4*)(g + 4);
                v4u o; o.x = pk2(f[0] * rstd * g0.x, f[1] * rstd * g0.y); o.y = pk2(f[2] * rstd * g0.z, f[3] * rstd * g0.w); o.z = pk2(f[4] * rstd * g1.x, f[5] * rstd * g1.y); o.w = pk2(f[6] * rstd * g1.z, f[7] * rstd * g1.w);
                *(GAS v4u*)(row + col) = o; }
        }
    }
}

template <int G, int NSEG, bool SINK>
__device__ __forceinline__ void band_attn_naive(Frame& F, const bf16* P, int pitch, int segstride, int kbase, int vbase, bf16* O, int opitch, const float* sinks, int nslope) {
    constexpr int NSLOT = SINK ? 2 : 3, NKEYS = SINK ? 128 : 129;
    LAS float* qs = (LAS float*)(F.lds + RING_OFF + F.wave * 16384);
    LAS float* ps = qs + NSEG * G * 64;
    for (int item = F.gw; item < M * 4; item += F.NGW) {
        const int m = item >> 2, kvh = item & 3, t = m & (S - 1);
        asm volatile("" ::: "memory");
#pragma unroll
        for (int sg = 0; sg < NSEG; ++sg)
#pragma unroll
            for (int g = 0; g < G; ++g) qs[(sg * G + g) * 64 + F.lane] = bf2f(P[(size_t)m * pitch + sg * segstride + (kvh * G + g) * 64 + F.lane]);
        LDS_WAIT(); asm volatile("" ::: "memory");
        float lg[NSEG][NSLOT][G];
#pragma unroll
        for (int sg = 0; sg < NSEG; ++sg) {
            const int dil = sg == 0 ? 1 : (sg == 1 ? 4 : 16);
#pragma unroll
            for (int sl = 0; sl < NSLOT; ++sl) {
                asm volatile("" ::: "memory");
                const int j = sl * 64 + F.lane; const bool valid = (j < NKEYS) && (t - j * dil >= 0);
                const bf16* kr = P + (size_t)(m - (valid ? j * dil : 0)) * pitch + sg * segstride + kbase + kvh * 64;
                float kf[64];
#pragma unroll
                for (int i = 0; i < 8; ++i) { const v4u w = *(const GAS v4u*)(kr + 8 * i); unpack8(w, kf + 8 * i); }
#pragma unroll
                for (int g = 0; g < G; ++g) { float dot = 0.f;
#pragma unroll
                    for (int d4 = 0; d4 < 16; ++d4) { const f32x4 q4 = *(const LAS f32x4*)(qs + (sg * G + g) * 64 + 4 * d4); dot += kf[4 * d4] * q4.x + kf[4 * d4 + 1] * q4.y + kf[4 * d4 + 2] * q4.z + kf[4 * d4 + 3] * q4.w; }
                    const float slope = exp2f(-8.f * (float)(kvh * G + g + 1) / (float)nslope);
                    lg[sg][sl][g] = valid ? dot * 0.125f - slope * (float)(j * dil) : -INFINITY; }
            }
        }
#pragma unroll
        for (int g = 0; g < G; ++g) {
            float mx = -INFINITY;
#pragma unroll
            for (int sg = 0; sg < NSEG; ++sg)
#pragma unroll
                for (int sl = 0; sl < NSLOT; ++sl) mx = fmaxf(mx, lg[sg][sl][g]);
            mx = wave_max(mx);
            float sk = 0.f; if (SINK) { sk = sinks[kvh * G + g]; mx = fmaxf(mx, sk); }
            float sum = 0.f;
#pragma unroll
            for (int sg = 0; sg < NSEG; ++sg)
#pragma unroll
                for (int sl = 0; sl < NSLOT; ++sl) { const float e = __expf(lg[sg][sl][g] - mx); lg[sg][sl][g] = e; sum += e; }
            sum = wave_sum(sum); if (SINK) sum += __expf(sk - mx);
            const float inv = 1.0f / sum;
#pragma unroll
            for (int sg = 0; sg < NSEG; ++sg)
#pragma unroll
                for (int sl = 0; sl < NSLOT; ++sl) ps[(sg * 192 + sl * 64 + F.lane) * G + g] = lg[sg][sl][g] * inv;
        }
        LDS_WAIT(); asm volatile("" ::: "memory");
        float o[G];
#pragma unroll
        for (int g = 0; g < G; ++g) o[g] = 0.f;
#pragma unroll
        for (int sg = 0; sg < NSEG; ++sg) {
            const int dil = sg == 0 ? 1 : (sg == 1 ? 4 : 16);
            const int jmax = min(NKEYS - 1, t / dil);
            const bf16* vb = P + (size_t)m * pitch + sg * segstride + vbase + kvh * 64 + F.lane;
            for (int j0 = 0; j0 <= jmax; j0 += 8) {
                float v[8];
#pragma unroll
                for (int u = 0; u < 8; ++u) { const int jj = min(j0 + u, jmax); v[u] = bf2f(vb[-(ptrdiff_t)jj * dil * pitch]); }
#pragma unroll
                for (int u = 0; u < 8; ++u)
#pragma unroll
                    for (int g4 = 0; g4 < G; g4 += 4) { const f32x4 p4 = *(const LAS f32x4*)(ps + (sg * 192 + j0 + u) * G + g4); o[g4] += p4.x * v[u]; o[g4 + 1] += p4.y * v[u]; o[g4 + 2] += p4.z * v[u]; o[g4 + 3] += p4.w * v[u]; }
            }
        }
#pragma unroll
        for (int g = 0; g < G; ++g) O[(size_t)m * opitch + (kvh * G + g) * 64 + F.lane] = (bf16)f2bf(o[g]);
    }
}

__device__ __forceinline__ void dsa_latnorm_phase(Frame& F, const bf16* LAT, bf16* QL, bf16* KVL, const float* qg, const float* kvg) {
    for (int m = F.gw; m < M; m += F.NGW) {
        const bf16* row = LAT + (size_t)m * DSA_INP;
        float f[8]; { const v4u w = *(const GAS v4u*)(row + 8 * F.lane); unpack8(w, f); }
        float ss = 0.f;
#pragma unroll
        for (int e = 0; e < 8; ++e) ss += f[e] * f[e];
        const float rq = 1.0f / sqrtf(wave_sum(ss) * (1.f / 512.f) + EPS);
        { const f32x4 g0 = *(const f32x4*)(qg + 8 * F.lane), g1 = *(const f32x4*)(qg + 8 * F.lane + 4);
          v4u o; o.x = pk2(f[0] * rq * g0.x, f[1] * rq * g0.y); o.y = pk2(f[2] * rq * g0.z, f[3] * rq * g0.w); o.z = pk2(f[4] * rq * g1.x, f[5] * rq * g1.y); o.w = pk2(f[6] * rq * g1.z, f[7] * rq * g1.w);
          *(GAS v4u*)(QL + (size_t)m * 512 + 8 * F.lane) = o; }
        float h[8]; float s2 = 0.f; const bool act = F.lane < 32;
        if (act) { const v4u w = *(const GAS v4u*)(row + 512 + 8 * F.lane); unpack8(w, h);
#pragma unroll
            for (int e = 0; e < 8; ++e) s2 += h[e] * h[e]; }
        s2 += __shfl_xor(s2, 1); s2 += __shfl_xor(s2, 2); s2 += __shfl_xor(s2, 4); s2 += __shfl_xor(s2, 8); s2 += __shfl_xor(s2, 16);
        if (act) { const float rk = 1.0f / sqrtf(s2 * (1.f / 256.f) + EPS); const f32x4 g0 = *(const f32x4*)(kvg + 8 * F.lane), g1 = *(const f32x4*)(kvg + 8 * F.lane + 4);
          v4u o; o.x = pk2(h[0] * rk * g0.x, h[1] * rk * g0.y); o.y = pk2(h[2] * rk * g0.z, h[3] * rk * g0.w); o.z = pk2(h[4] * rk * g1.x, h[5] * rk * g1.y); o.w = pk2(h[6] * rk * g1.z, h[7] * rk * g1.w);
          *(GAS v4u*)(KVL + (size_t)m * 256 + 8 * F.lane) = o; }
    }
}

__device__ __forceinline__ void dsa_qknorm(Frame& F, bf16* QQ, bf16* KV, const float* qn, const float* kn) {
    for (int m = F.gw; m < M; m += F.NGW) {
#pragma unroll
        for (int c = 0; c < 5; ++c) {
            const bool act = c < 4 || F.lane < 16;
            bf16* p = c < 4 ? QQ + (size_t)m * DSA_QQ + 512 * c + 8 * F.lane : KV + (size_t)m * 256 + 8 * F.lane;
            const float* g = (c < 4 ? qn : kn) + ((8 * F.lane) & 127);
            float f[8]; float ss = 0.f;
            if (act) { const v4u w = *(const GAS v4u*)p; unpack8(w, f);
#pragma unroll
                for (int e = 0; e < 8; ++e) ss += f[e] * f[e]; }
            ss += __shfl_xor(ss, 1); ss += __shfl_xor(ss, 2); ss += __shfl_xor(ss, 4); ss += __shfl_xor(ss, 8);
            if (act) { const float r = 1.0f / sqrtf(ss * (1.f / 128.f) + EPS); const f32x4 g0 = *(const f32x4*)g, g1 = *(const f32x4*)(g + 4);
                v4u o; o.x = pk2(f[0] * r * g0.x, f[1] * r * g0.y); o.y = pk2(f[2] * r * g0.z, f[3] * r * g0.w); o.z = pk2(f[4] * r * g1.x, f[5] * r * g1.y); o.w = pk2(f[6] * r * g1.z, f[7] * r * g1.w);
                *(GAS v4u*)p = o; }
        }
    }
}

__device__ __forceinline__ unsigned f2key(float x) { const unsigned u = __float_as_uint(x); return (u & 0x80000000u) ? ~u : (u | 0x80000000u); }
__device__ __forceinline__ void dsa_index_naive(Frame& F, const bf16* LAT, const bf16* QQ, unsigned short* IDX, int* NSEL) {
    LAS float* qi = (LAS float*)(F.lds + RING_OFF + F.wave * 16384);
    LAS unsigned* skey = (LAS unsigned*)(qi + 1024);
    LAS float* wl = (LAS float*)(skey + 2048);
    const unsigned long long ltmask = (1ull << F.lane) - 1ull;
    for (int m = F.gw; m < M; m += F.NGW) {
        const int t = m & (S - 1), b0 = m - t;
        if (t < 256) {
            for (int jj = F.lane; jj < 256; jj += 64) if (jj <= t) IDX[(size_t)m * 256 + jj] = (unsigned short)jj;
            if (F.lane == 0) NSEL[m] = t + 1;
            continue;
        }
        asm volatile("" ::: "memory");
#pragma unroll
        for (int r = 0; r < 2; ++r) { const int e = (r * 64 + F.lane) * 8; const v4u w = *(const GAS v4u*)(QQ + (size_t)m * DSA_QQ + 2048 + e); float f[8]; unpack8(w, f);
#pragma unroll
            for (int i = 0; i < 8; ++i) qi[e + i] = f[i]; }
        if (F.lane < 16) wl[F.lane] = bf2f(LAT[(size_t)m * DSA_INP + 832 + F.lane]) * (0.25f * 0.125f);
        LDS_WAIT(); asm volatile("" ::: "memory");
        const int nch = (t >> 6) + 1;
#pragma unroll 1
        for (int c = 0; c < nch; ++c) {
            asm volatile("" ::: "memory");
            const int s = c * 64 + F.lane; const bool valid = s <= t;
            const bf16* kr = LAT + (size_t)(b0 + (valid ? s : t)) * DSA_INP + 768;
            v4u kw[8];
#pragma unroll
            for (int i = 0; i < 8; ++i) kw[i] = *(const GAS v4u*)(kr + 8 * i);
            float kf[64];
#pragma unroll
            for (int i = 0; i < 8; ++i) unpack8(kw[i], kf + 8 * i);
            float sc = 0.f;
#pragma unroll 1
            for (int h = 0; h < 16; ++h) {
                float dot = 0.f;
#pragma unroll
                for (int d4 = 0; d4 < 16; ++d4) { const f32x4 q4 = *(const LAS f32x4*)(qi + h * 64 + 4 * d4); dot += (kf[4 * d4] * q4.x + kf[4 * d4 + 1] * q4.y) + (kf[4 * d4 + 2] * q4.z + kf[4 * d4 + 3] * q4.w); }
                sc += wl[h] * fmaxf(dot, 0.f);
            }
            skey[s] = valid ? f2key(sc) : 0u;
        }
        LDS_WAIT(); asm volatile("" ::: "memory");
        unsigned key[32];
#pragma unroll
        for (int c = 0; c < 32; ++c) key[c] = (c < nch) ? skey[c * 64 + F.lane] : 0u;
        unsigned T = 0u;
        for (int bit = 31; bit >= 0; --bit) {
            const unsigned cand = T | (1u << bit); int cnt = 0;
#pragma unroll
            for (int c = 0; c < 32; ++c) cnt += __popcll(__ballot(key[c] >= cand));
            if (cnt >= 256) T = cand;
        }
        int cgt = 0;
#pragma unroll
        for (int c = 0; c < 32; ++c) cgt += __popcll(__ballot(key[c] > T));
        const int need_eq = 256 - cgt;
        int base = 0, eqbase = 0;
#pragma unroll
        for (int c = 0; c < 32; ++c) {
            const bool gt = key[c] > T, eq = key[c] == T;
            const unsigned long long meq = __ballot(eq);
            const int eqrank = eqbase + __popcll(meq & ltmask);
            const bool sel = gt || (eq && eqrank < need_eq);
            const unsigned long long msel = __ballot(sel);
            const int pos = base + __popcll(msel & ltmask);
            if (sel && pos < 256) IDX[(size_t)m * 256 + pos] = (unsigned short)(c * 64 + F.lane);
            base += __popcll(msel); eqbase += __popcll(meq);
        }
        if (F.lane == 0) NSEL[m] = base < 256 ? base : 256;
    }
}

__device__ __forceinline__ void dsa_attn_naive(Frame& F, const bf16* QQ, const bf16* KV, const unsigned short* IDX, const int* NSEL, bf16* O) {
    LAS float* qs = (LAS float*)(F.lds + RING_OFF + F.wave * 16384);
    LAS float* ps = qs + 2048;
    for (int m = F.gw; m < M; m += F.NGW) {
        const int t = m & (S - 1), b0 = m - t; const int n = NSEL[m];
        asm volatile("" ::: "memory");
#pragma unroll
        for (int r = 0; r < 4; ++r) { const int e = (r * 64 + F.lane) * 8; const v4u w = *(const GAS v4u*)(QQ + (size_t)m * DSA_QQ + e); float f[8]; unpack8(w, f);
            *(LAS f32x4*)(qs + e) = (f32x4){f[0], f[1], f[2], f[3]}; *(LAS f32x4*)(qs + e + 4) = (f32x4){f[4], f[5], f[6], f[7]}; }
        LDS_WAIT(); asm volatile("" ::: "memory");
        int sidx[4];
#pragma unroll
        for (int sl = 0; sl < 4; ++sl) { const int jj = sl * 64 + F.lane; sidx[sl] = (jj < n) ? (int)IDX[(size_t)m * 256 + jj] : 0; }
#pragma unroll 1
        for (int hh = 0; hh < 2; ++hh) {
#pragma unroll 1
            for (int sl = 0; sl < 4; ++sl) {
                const int jj = sl * 64 + F.lane; const bool val = jj < n; const int sx = val ? (int)IDX[(size_t)m * 256 + jj] : 0;
                const bf16* kr = KV + (size_t)(b0 + sx) * 256;
                float kf[128];
#pragma unroll
                for (int i = 0; i < 16; ++i) { const v4u w = *(const GAS v4u*)(kr + 8 * i); unpack8(w, kf + 8 * i); }
#pragma unroll 1
                for (int h = 0; h < 8; ++h) {
                    const LAS float* qh = qs + (hh * 8 + h) * 128; float dot = 0.f;
#pragma unroll
                    for (int d4 = 0; d4 < 32; ++d4) { const f32x4 q4 = *(const LAS f32x4*)(qh + 4 * d4); dot += (kf[4 * d4] * q4.x + kf[4 * d4 + 1] * q4.y) + (kf[4 * d4 + 2] * q4.z + kf[4 * d4 + 3] * q4.w); }
                    const float slope = exp2f(-0.5f * (float)(hh * 8 + h + 1));
                    ps[jj * 8 + h] = val ? dot * 0.08838834764831845f - slope * (float)(t - sx) : -INFINITY;
                }
            }
            LDS_WAIT(); asm volatile("" ::: "memory");
            float inv_sum[8];
#pragma unroll
            for (int h = 0; h < 8; ++h) {
                float l0 = ps[(F.lane) * 8 + h], l1 = ps[(64 + F.lane) * 8 + h], l2 = ps[(128 + F.lane) * 8 + h], l3 = ps[(192 + F.lane) * 8 + h];
                const float mx = wave_max(fmaxf(fmaxf(l0, l1), fmaxf(l2, l3)));
                l0 = __expf(l0 - mx); l1 = __expf(l1 - mx); l2 = __expf(l2 - mx); l3 = __expf(l3 - mx);
                inv_sum[h] = 1.0f / wave_sum((l0 + l1) + (l2 + l3));
                ps[(F.lane) * 8 + h] = l0; ps[(64 + F.lane) * 8 + h] = l1; ps[(128 + F.lane) * 8 + h] = l2; ps[(192 + F.lane) * 8 + h] = l3;
            }
            LDS_WAIT(); asm volatile("" ::: "memory");
            float o[8][2];
#pragma unroll
            for (int h = 0; h < 8; ++h) { o[h][0] = 0.f; o[h][1] = 0.f; }
#pragma unroll
            for (int sl = 0; sl < 4; ++sl) {
                if (sl * 64 < n) {
#pragma unroll 1
                    for (int j0 = 0; j0 < 64; j0 += 4) {
                        unsigned vw[4];
#pragma unroll
                        for (int u = 0; u < 4; ++u) { const int sx = __builtin_amdgcn_readlane(sidx[sl], j0 + u); vw[u] = *(const GAS unsigned*)(KV + (size_t)(b0 + sx) * 256 + 128 + 2 * F.lane); }
#pragma unroll
                        for (int u = 0; u < 4; ++u) {
                            const float v0 = bflo(vw[u]), v1 = bfhi(vw[u]); const int jj = sl * 64 + j0 + u;
                            const f32x4 p0 = *(const LAS f32x4*)(ps + jj * 8), p1 = *(const LAS f32x4*)(ps + jj * 8 + 4);
                            o[0][0] += p0.x * v0; o[0][1] += p0.x * v1; o[1][0] += p0.y * v0; o[1][1] += p0.y * v1; o[2][0] += p0.z * v0; o[2][1] += p0.z * v1; o[3][0] += p0.w * v0; o[3][1] += p0.w * v1;
                            o[4][0] += p1.x * v0; o[4][1] += p1.x * v1; o[5][0] += p1.y * v0; o[5][1] += p1.y * v1; o[6][0] += p1.z * v0; o[6][1] += p1.z * v1; o[7][0] += p1.w * v0; o[7][1] += p1.w * v1;
                        }
                    }
                }
            }
#pragma unroll
            for (int h = 0; h < 8; ++h) *(GAS unsigned*)(O + (size_t)m * D + (hh * 8 + h) * 128 + 2 * F.lane) = pk2(o[h][0] * inv_sum[h], o[h][1] * inv_sum[h]);
            LDS_WAIT(); asm volatile("" ::: "memory");
        }
    }
}
typedef short bf16x8v __attribute__((ext_vector_type(8)));
typedef float f32x16v __attribute__((ext_vector_type(16)));
__device__ __forceinline__ bf16x8v ld_frag(const bf16* p) { return __builtin_bit_cast(bf16x8v, *(const GAS v4u*)p); }
__device__ __forceinline__ bf16x8v pack_frag(float a0, float a1, float a2, float a3, float a4, float a5, float a6, float a7) {
    v4u w; w.x = pg8::cvt_pk_bf16(a0, a1); w.y = pg8::cvt_pk_bf16(a2, a3); w.z = pg8::cvt_pk_bf16(a4, a5); w.w = pg8::cvt_pk_bf16(a6, a7); return __builtin_bit_cast(bf16x8v, w); }
template <int G, bool SINK>
__device__ __forceinline__ void band_attn_mfma(Frame& F, const bf16* P, int pitch, int qcol0, int kcol0, const bf16* VT, int dshift, bf16* Ob, int opitch, int ocol0, float* LSE, const float* sinks, int nheads_total) {
    constexpr int QPI = 32 / G, WMAX = SINK ? 127 : 128;
    const int Ssub = S >> dshift, per = Ssub / QPI, nitems = BATCH * 4 * (S / QPI);
    const int l31 = F.lane & 31, hh = F.lane >> 5;
    const int kperm = (l31 & ~12) | ((l31 & 4) << 1) | ((l31 & 8) >> 1);
    const int qi = l31 / G, hd = l31 % G;
    for (int item = F.gw; item < nitems; item += F.NGW) {
        const int qg = item % per, rest = item / per, r = rest & ((1 << dshift) - 1), rest2 = rest >> dshift, kvh = rest2 & 3, b = rest2 >> 2;
        const int u0 = qg * QPI, kstart = (u0 - 128) & ~7;
        const int u = u0 + qi, head = kvh * G + hd;
        const size_t m = (size_t)b * S + ((size_t)u << dshift) + r;
        const float slope = exp2f(-8.f * (float)(head + 1) / (float)nheads_total) * (float)(1 << dshift);
        bf16x8v qf[4];
#pragma unroll
        for (int ks = 0; ks < 4; ++ks) qf[ks] = ld_frag(P + m * pitch + qcol0 + head * 64 + 16 * ks + 8 * hh);
        f32x16v sT[5];
#pragma unroll
        for (int T = 0; T < 5; ++T) {
            const int tb = kstart + 32 * T;
            int sl = tb + kperm; sl = sl < 0 ? 0 : (sl > Ssub - 1 ? Ssub - 1 : sl);
            const bf16* kr = P + ((size_t)b * S + ((size_t)sl << dshift) + r) * pitch + kcol0 + kvh * 64 + 8 * hh;
            bf16x8v kf[4];
#pragma unroll
            for (int ks = 0; ks < 4; ++ks) kf[ks] = ld_frag(kr + 16 * ks);
            f32x16v acc;
#pragma unroll
            for (int e = 0; e < 16; ++e) acc[e] = 0.f;
#pragma unroll
            for (int ks = 0; ks < 4; ++ks) acc = __builtin_amdgcn_mfma_f32_32x32x16_bf16(kf[ks], qf[ks], acc, 0, 0, 0);
#pragma unroll
            for (int e = 0; e < 16; ++e) { const int ko = 16 * (e >> 3) + 8 * hh + 4 * ((e >> 2) & 1) + (e & 3); const int s = tb + ko, dist = u - s;
                const bool valid = (dist >= 0) && (dist <= WMAX) && (s >= 0);
                acc[e] = valid ? acc[e] * 0.125f - slope * (float)dist : -INFINITY; }
            sT[T] = acc;
        }
        float mx = -INFINITY;
#pragma unroll
        for (int T = 0; T < 5; ++T)
#pragma unroll
            for (int e = 0; e < 16; ++e) mx = fmaxf(mx, sT[T][e]);
        mx = fmaxf(mx, __shfl_xor(mx, 32));
        float sk = 0.f; if (SINK) { sk = sinks[head]; mx = fmaxf(mx, sk); }
        float sum = 0.f;
#pragma unroll
        for (int T = 0; T < 5; ++T)
#pragma unroll
            for (int e = 0; e < 16; ++e) { const float p = __expf(sT[T][e] - mx); sT[T][e] = p; sum += p; }
        sum += __shfl_xor(sum, 32);
        if (SINK) sum += __expf(sk - mx);
        f32x16v oT[2];
#pragma unroll
        for (int c = 0; c < 2; ++c)
#pragma unroll
            for (int e = 0; e < 16; ++e) oT[c][e] = 0.f;
        const bf16* vbase = VT + ((size_t)(b * 4 + kvh) * 64 + l31) * S + (size_t)r * Ssub;
#pragma unroll
        for (int T = 0; T < 5; ++T)
#pragma unroll
            for (int s2 = 0; s2 < 2; ++s2) {
                int kb = kstart + 32 * T + 16 * s2 + 8 * hh; kb = kb < 0 ? 0 : (kb > Ssub - 8 ? Ssub - 8 : kb);
                const bf16x8v pb = pack_frag(sT[T][8 * s2], sT[T][8 * s2 + 1], sT[T][8 * s2 + 2], sT[T][8 * s2 + 3], sT[T][8 * s2 + 4], sT[T][8 * s2 + 5], sT[T][8 * s2 + 6], sT[T][8 * s2 + 7]);
#pragma unroll
                for (int c = 0; c < 2; ++c) { const bf16x8v vf = ld_frag(vbase + (size_t)(32 * c) * S + kb); oT[c] = __builtin_amdgcn_mfma_f32_32x32x16_bf16(vf, pb, oT[c], 0, 0, 0); }
            }
        const float inv = 1.0f / sum;
        bf16* orow = Ob + m * opitch + ocol0 + head * 64 + 4 * hh;
#pragma unroll
        for (int c = 0; c < 2; ++c)
#pragma unroll
            for (int r4 = 0; r4 < 4; ++r4) { v2u w; w.x = pg8::cvt_pk_bf16(oT[c][4 * r4] * inv, oT[c][4 * r4 + 1] * inv); w.y = pg8::cvt_pk_bf16(oT[c][4 * r4 + 2] * inv, oT[c][4 * r4 + 3] * inv);
                *(GAS v2u*)(orow + 32 * c + 8 * r4) = w; }
        if (!SINK) { if (hh == 0) LSE[m * 16 + head] = mx + __logf(sum); }
    }
}
__device__ __forceinline__ void dil_combine(Frame& F, const bf16* P, const float* LSE, bf16* O) {
    for (int m = F.gw; m < M; m += F.NGW) {
#pragma unroll
        for (int i = 0; i < 2; ++i) {
            const int col = 8 * F.lane + 512 * i, head = col >> 6;
            const float l0 = LSE[(size_t)m * 16 + head], l1 = LSE[(size_t)(M + m) * 16 + head], l2 = LSE[(size_t)(2 * M + m) * 16 + head];
            const float mx = fmaxf(l0, fmaxf(l1, l2)); float w0 = __expf(l0 - mx), w1 = __expf(l1 - mx), w2 = __expf(l2 - mx); const float inv = 1.0f / (w0 + w1 + w2); w0 *= inv; w1 *= inv; w2 *= inv;
            float a[8], bq[8], c[8];
            unpack8(*(const GAS v4u*)(P + (size_t)m * DIL_IN + col), a); unpack8(*(const GAS v4u*)(P + (size_t)m * DIL_IN + 1536 + col), bq); unpack8(*(const GAS v4u*)(P + (size_t)m * DIL_IN + 3072 + col), c);
            v4u o; o.x = pk2(w0 * a[0] + w1 * bq[0] + w2 * c[0], w0 * a[1] + w1 * bq[1] + w2 * c[1]); o.y = pk2(w0 * a[2] + w1 * bq[2] + w2 * c[2], w0 * a[3] + w1 * bq[3] + w2 * c[3]);
            o.z = pk2(w0 * a[4] + w1 * bq[4] + w2 * c[4], w0 * a[5] + w1 * bq[5] + w2 * c[5]); o.w = pk2(w0 * a[6] + w1 * bq[6] + w2 * c[6], w0 * a[7] + w1 * bq[7] + w2 * c[7]);
            *(GAS v4u*)(O + (size_t)m * 1024 + col) = o;
        }
    }
}
__device__ __forceinline__ void dsa_fused(Frame& F, const bf16* LAT, const bf16* QQ, const bf16* KV, const bf16* VT, bf16* O) {
    LAS unsigned* sk = (LAS unsigned*)(F.lds + RING_OFF + F.wave * 16384);
    const int l31 = F.lane & 31, hh = F.lane >> 5;
    const int kperm = (l31 & ~12) | ((l31 & 4) << 1) | ((l31 & 8) >> 1);
    constexpr int NITEM = M / 2, PER_B = S / 2;
    int pass = 0;
    for (int item = F.gw; item < NITEM; item += F.NGW, ++pass) {
        const int b = item / PER_B; int tp = item % PER_B; if (pass & 1) tp = PER_B - 1 - tp;
        const int t0 = 2 * tp; const size_t b0 = (size_t)b * S, m0 = b0 + t0;
        const int ntile = ((t0 + 1) >> 5) + 1;
        asm volatile("" ::: "memory");
        {
            bf16x8v af[4];
            { const int qsel = (l31 >> 2) & 1, head = (l31 >> 3) * 4 + (l31 & 3);
#pragma unroll
              for (int ks = 0; ks < 4; ++ks) af[ks] = ld_frag(QQ + (m0 + qsel) * DSA_QQ + 2048 + head * 64 + 16 * ks + 8 * hh); }
            float wv[16];
            { float f[8]; unpack8(*(const GAS v4u*)(LAT + (m0 + hh) * DSA_INP + 832), f);
#pragma unroll
              for (int e = 0; e < 8; ++e) wv[e] = f[e] * (0.25f * 0.125f);
              unpack8(*(const GAS v4u*)(LAT + (m0 + hh) * DSA_INP + 840), f);
#pragma unroll
              for (int e = 0; e < 8; ++e) wv[8 + e] = f[e] * (0.25f * 0.125f); }
            const int tq = t0 + hh;
#pragma unroll 1
            for (int T = 0; T < ntile; ++T) {
                const int s = 32 * T + l31;
                const bf16* kr = LAT + (b0 + s) * DSA_INP + 768 + 8 * hh;
                f32x16v acc;
#pragma unroll
                for (int e = 0; e < 16; ++e) acc[e] = 0.f;
#pragma unroll
                for (int ks = 0; ks < 4; ++ks) acc = __builtin_amdgcn_mfma_f32_32x32x16_bf16(af[ks], ld_frag(kr + 16 * ks), acc, 0, 0, 0);
                float sc = 0.f;
#pragma unroll
                for (int e = 0; e < 16; ++e) sc = __builtin_fmaf(wv[e], fmaxf(acc[e], 0.f), sc);
                sk[hh * 2048 + s] = (s <= tq) ? f2key(sc) : 0u;
            }
        }
        LDS_WAIT(); asm volatile("" ::: "memory");
        unsigned Tsel[2];
#pragma unroll
        for (int q = 0; q < 2; ++q) {
            const int tq = t0 + q;
            unsigned T = 1u;
            if (tq >= 256) {
                const int nch = (tq >> 6) + 1;
                unsigned key[32];
#pragma unroll
                for (int c = 0; c < 32; ++c) key[c] = (c < nch && c * 64 + F.lane <= tq) ? sk[q * 2048 + c * 64 + F.lane] : 0u;
                T = 0u;
#pragma unroll 1
                for (int bit = 31; bit >= 0; --bit) {
                    const unsigned cand = T | (1u << bit); int cnt = 0;
#pragma unroll
                    for (int c = 0; c < 32; ++c) cnt += __popcll(__ballot(key[c] >= cand));
                    if (cnt >= 256) T = cand;
                }
            }
            Tsel[q] = T;
        }
        const int qsel = l31 >> 4, head = l31 & 15, tq = t0 + qsel;
        const unsigned Tm = qsel ? Tsel[1] : Tsel[0];
        const float slope = exp2f(-0.5f * (float)(head + 1));
        bf16x8v qf[8];
#pragma unroll
        for (int ks = 0; ks < 8; ++ks) qf[ks] = ld_frag(QQ + (m0 + qsel) * DSA_QQ + head * 128 + 16 * ks + 8 * hh);
        f32x16v oT[4];
#pragma unroll
        for (int c = 0; c < 4; ++c)
#pragma unroll
            for (int e = 0; e < 16; ++e) oT[c][e] = 0.f;
        float mrun = -INFINITY, lrun = 0.f;
        const bf16* vbase = VT + ((size_t)b * 128 + l31) * S + 8 * hh;
#pragma unroll 1
        for (int T = 0; T < ntile; ++T) {
            const int tb = 32 * T;
            const bf16* kr = KV + (b0 + tb + kperm) * 256 + 8 * hh;
            f32x16v acc;
#pragma unroll
            for (int e = 0; e < 16; ++e) acc[e] = 0.f;
#pragma unroll
            for (int ks = 0; ks < 8; ++ks) acc = __builtin_amdgcn_mfma_f32_32x32x16_bf16(ld_frag(kr + 16 * ks), qf[ks], acc, 0, 0, 0);
            float tmax = -INFINITY;
#pragma unroll
            for (int e4 = 0; e4 < 4; ++e4) {
                const int ko4 = 16 * (e4 >> 1) + 8 * hh + 4 * (e4 & 1);
                const v4u k4 = *(const LAS v4u*)(sk + qsel * 2048 + tb + ko4);
#pragma unroll
                for (int i = 0; i < 4; ++i) { const int e = 4 * e4 + i; const int s = tb + ko4 + i; const unsigned kk = i == 0 ? k4.x : (i == 1 ? k4.y : (i == 2 ? k4.z : k4.w));
                    const float lg = (kk >= Tm) ? acc[e] * 0.08838834764831845f - slope * (float)(tq - s) : -INFINITY; acc[e] = lg; tmax = fmaxf(tmax, lg); }
            }
            tmax = fmaxf(tmax, __shfl_xor(tmax, 32));
            const float mnew = fmaxf(mrun, tmax), msub = (mnew == -INFINITY) ? 0.f : mnew;
            const float alpha = __expf(mrun - msub);
            mrun = mnew;
            float ps = 0.f;
#pragma unroll
            for (int e = 0; e < 16; ++e) { const float p = __expf(acc[e] - msub); acc[e] = p; ps += p; }
            lrun = lrun * alpha + ps;
            if (__any(alpha != 1.0f)) {
#pragma unroll
                for (int c = 0; c < 4; ++c)
#pragma unroll
                    for (int e = 0; e < 16; ++e) oT[c][e] *= alpha;
            }
#pragma unroll
            for (int s2 = 0; s2 < 2; ++s2) {
                const bf16x8v pb = pack_frag(acc[8 * s2], acc[8 * s2 + 1], acc[8 * s2 + 2], acc[8 * s2 + 3], acc[8 * s2 + 4], acc[8 * s2 + 5], acc[8 * s2 + 6], acc[8 * s2 + 7]);
#pragma unroll
                for (int c = 0; c < 4; ++c) oT[c] = __builtin_amdgcn_mfma_f32_32x32x16_bf16(ld_frag(vbase + (size_t)(32 * c) * S + tb + 16 * s2), pb, oT[c], 0, 0, 0);
            }
        }
        lrun += __shfl_xor(lrun, 32);
        const float inv = 1.0f / lrun;
        bf16* orow = O + (m0 + qsel) * D + head * 128 + 4 * hh;
#pragma unroll
        for (int c = 0; c < 4; ++c)
#pragma unroll
            for (int r4 = 0; r4 < 4; ++r4) { v2u w; w.x = pg8::cvt_pk_bf16(oT[c][4 * r4] * inv, oT[c][4 * r4 + 1] * inv); w.y = pg8::cvt_pk_bf16(oT[c][4 * r4 + 2] * inv, oT[c][4 * r4 + 3] * inv);
                *(GAS v2u*)(orow + 32 * c + 8 * r4) = w; }
        LDS_WAIT(); asm volatile("" ::: "memory");
    }
}
#define GRID_BAR() xcd_barrier(bar)
struct Args { const float* in[26]; float* out; unsigned char* ws; };
template <int L>
__device__ __forceinline__ void layer_fwd(Frame& F, const Args& args, const XcdBarrier& bar) {
    unsigned char* ws = args.ws;
    const float* x_in = args.in[0];
    float* out = args.out;
    float* MOD = (float*)(ws + WS_MOD);
    bf16* H = (bf16*)(ws + WS_H);
    bf16* PROJ = (bf16*)(ws + WS_PROJ);
    bf16* OB = (bf16*)(ws + WS_O);
    bf16* VT = (bf16*)(ws + WS_VT); float* LSE = (float*)(ws + WS_LSE); bf16* VTD = (bf16*)(ws + WS_VTD);
    bf16* HID = (bf16*)(ws + WS_BIG);
    bf16* LAT = (bf16*)(ws + WS_LAT); bf16* QL = (bf16*)(ws + WS_QL); bf16* KVL = (bf16*)(ws + WS_KVL); bf16* KV = (bf16*)(ws + WS_KV);
    bf16* QQ = (bf16*)(ws + WS_QQ);
    {
        constexpr int l = L, kind = L % 3, j = L / 3;
        const float* modl = MOD + (size_t)l * 8 * 12288;
        const float* xcur = (l == 0) ? x_in : out;
        norm_phase(F, xcur, args.in[4] + l * D, modl, 0, 2048, H);
        GRID_BAR();
        {
            const bf16* Wt = kind == 0 ? (const bf16*)(ws + WS_SWA_IN_T) + (size_t)j * SWA_IN * D : (kind == 1 ? (const bf16*)(ws + WS_DSA_IN_T) : (const bf16*)(ws + WS_DIL_IN_T));
            const int Nin = kind == 0 ? SWA_IN : (kind == 1 ? DSA_INP : DIL_IN);
            pg8::Gemm g{H, Wt, M, Nin, D}; pg8::StaticOrder So; So.init(M, Nin, F.G, (int)blockIdx.x);
            pg8::EpiQKV E{PROJ, Nin, VT, kind == 0 ? 16 : (kind == 1 ? 1 : 6), kind == 0 ? 9 : 5, S};
            pg8::gemm_phase<pg8::EpiQKV, pg8::StaticOrder, true, true>(F.lds + RING_OFF, g, So, E);
        }
        GRID_BAR();
        if constexpr (kind == 0) {
            qknorm_phase<0>(F, PROJ, SWA_IN, args.in[9] + j * 64, args.in[10] + j * 64);
            GRID_BAR();
            band_attn_mfma<8, true>(F, PROJ, SWA_IN, 0, 2048, VT, 0, OB, D, 0, nullptr, args.in[11] + j * 32, 32);
        } else if constexpr (kind == 1) {
            dsa_latnorm_phase(F, LAT, QL, KVL, args.in[14], args.in[15]);
            GRID_BAR();
            {
                pg8::Gemm g{QL, (const bf16*)(ws + WS_DSA_UQ_T), M, DSA_QQ, 512}; pg8::StaticOrder So; So.init(M, DSA_QQ, F.G, (int)blockIdx.x);
                pg8::EpiBf16S<0> E{QQ, DSA_QQ};
                pg8::gemm_phase<pg8::EpiBf16S<0>, pg8::StaticOrder, true, true>(F.lds + RING_OFF, g, So, E);
            }
            __syncthreads();
            {
                pg8::Gemm g{KVL, (const bf16*)(ws + WS_DSA_UKV_T), M, 256, 256}; pg8::StaticOrder So; So.init(M, 256, F.G, (int)blockIdx.x);
                pg8::EpiKVd E{KV, 256, VTD, S};
                pg8::gemm_phase<pg8::EpiKVd, pg8::StaticOrder, true, true>(F.lds + RING_OFF, g, So, E);
            }
            GRID_BAR();
            dsa_qknorm(F, QQ, KV, args.in[19], args.in[20]);
            GRID_BAR();
            dsa_fused(F, LAT, QQ, KV, VTD, OB);
        } else {
            qknorm_phase<2>(F, PROJ, DIL_IN, args.in[23], args.in[24]);
            GRID_BAR();
#pragma unroll 1
            for (int gi = 0; gi < 3; ++gi)
                band_attn_mfma<4, false>(F, PROJ, DIL_IN, gi * 1536, gi * 1536 + 1024, VT + (size_t)gi * 8 * 4 * 64 * S, 2 * gi, PROJ, DIL_IN, gi * 1536, LSE + (size_t)gi * M * 16, nullptr, 16);
            GRID_BAR();
            dil_combine(F, PROJ, LSE, OB);
        }
        GRID_BAR();
        {
            const bf16* Wt = kind == 0 ? (const bf16*)(ws + WS_SWA_OUT_T) + (size_t)j * D * D : (kind == 1 ? (const bf16*)(ws + WS_DSA_OUT_T) : (const bf16*)(ws + WS_DIL_OUT_T));
            const int Ko = kind == 2 ? 1024 : D;
            pg8::Gemm g{OB, Wt, M, D, Ko}; pg8::StaticOrder So; So.init(M, D, F.G, (int)blockIdx.x);
            pg8::EpiResGate E{xcur, out, D, modl + 4096, 12288, S};
            pg8::gemm_phase<pg8::EpiResGate, pg8::StaticOrder, true, true>(F.lds + RING_OFF, g, So, E);
        }
        GRID_BAR();
        norm_phase(F, out, args.in[5] + l * D, modl, 6144, 8192, H);
        GRID_BAR();
        {
            pg8::Gemm g{H, (const bf16*)(ws + WS_W1T) + (size_t)l * FF * D, M, FF, D}; pg8::StaticOrder So; So.init(M, FF, F.G, (int)blockIdx.x);
            pg8::EpiBf16S<1> E{HID, FF};
            pg8::gemm_phase<pg8::EpiBf16S<1>, pg8::StaticOrder, true, true>(F.lds + RING_OFF, g, So, E);
        }
        GRID_BAR();
        {
            pg8::Gemm g{HID, (const bf16*)(ws + WS_W2T) + (size_t)l * D * FF, M, D, FF}; pg8::StaticOrder So; So.init(M, D, F.G, (int)blockIdx.x);
            pg8::EpiResGate E{out, out, D, modl + 10240, 12288, S};
            pg8::gemm_phase<pg8::EpiResGate, pg8::StaticOrder, true, true>(F.lds + RING_OFF, g, So, E);
        }
        GRID_BAR();
        }
}
__global__ void __launch_bounds__(NT, 2) fwd_kernel(Args args) {
    extern __shared__ __attribute__((aligned(16))) unsigned char lds[];
    Frame F;
    F.lds = (LAS unsigned char*)lds;
    F.tid = threadIdx.x; F.lane = F.tid & 63; F.wave = __builtin_amdgcn_readfirstlane(F.tid >> 6);
    F.G = gridDim.x; F.gw = blockIdx.x * NWAVES + F.wave; F.NGW = F.G * NWAVES;
    unsigned char* ws = args.ws;
    unsigned* ctl = (unsigned*)(ws + WS_CTL);
    for (int u = F.tid; u < (LDS_BYTES - LDSCTL_OFF) / 4; u += NT) ((LAS unsigned*)(F.lds + LDSCTL_OFF))[u] = 0u;
    __syncthreads();
    XcdBarrier bar = xcd_barrier_post(ctl + CW_BAR, (volatile LAS unsigned*)(F.lds + MISC_OFF) + 8);

    float* MOD = (float*)(ws + WS_MOD);

    p0_ada(F, args.in[1], args.in[2], args.in[3], MOD);
    __syncthreads();
    p0_weights(F, args.in, ws);
    GRID_BAR();

    layer_fwd<0>(F, args, bar);
    layer_fwd<1>(F, args, bar);
    layer_fwd<2>(F, args, bar);
    layer_fwd<3>(F, args, bar);
}

extern "C" void kernel_launch(void* const* d_in, const int* in_sizes, int n_in, void* d_out, int out_size, void* d_ws, size_t ws_size, hipStream_t stream) {
    static int grid = 0;
    if (grid == 0) {
        if (n_in != 26 || in_sizes[0] != M * D || out_size != M * D || ws_size < WS_END) { fprintf(stderr, "kernel_launch: unexpected shapes / workspace (n_in %d, ws %zu)\n", n_in, ws_size); grid = -1; return; }
        int dev = 0, cus = 0, per_cu = 0;
        if (hipGetDevice(&dev) != hipSuccess || hipDeviceGetAttribute(&cus, hipDeviceAttributeMultiprocessorCount, dev) != hipSuccess) { grid = -1; return; }
        if (hipFuncSetAttribute((const void*)fwd_kernel, hipFuncAttributeMaxDynamicSharedMemorySize, LDS_BYTES) != hipSuccess) { grid = -1; return; }
        if (hipOccupancyMaxActiveBlocksPerMultiprocessor(&per_cu, (const void*)fwd_kernel, NT, LDS_BYTES) != hipSuccess || per_cu < 1) { fprintf(stderr, "kernel_launch: occupancy query reports %d\n", per_cu); }
        (void)hipGetLastError();
        grid = cus;
    }
    if (grid < 0) return;
    if (hipMemsetAsync((char*)d_ws + WS_CTL, 0, CTL_ZERO_BYTES, stream) != hipSuccess) return;
    Args a{};
    for (int i = 0; i < 26; ++i) a.in[i] = (const float*)d_in[i];
    a.out = (float*)d_out; a.ws = (unsigned char*)d_ws;
    hipLaunchKernelGGL(fwd_kernel, dim3(grid), dim3(NT), LDS_BYTES, stream, a);
}
```

```cpp
#include <hip/hip_runtime.h>
#include <cstdio>
#include <cstdint>
#include <cmath>
#ifndef PROBE
#define PROBE 0
#endif
namespace pg8 {
#define PG8_LAS __attribute__((address_space(3)))
typedef unsigned short bf16_t;
typedef short bf16x8 __attribute__((ext_vector_type(8)));
typedef float f32x4 __attribute__((ext_vector_type(4)));
typedef unsigned u32x4 __attribute__((ext_vector_type(4)));
constexpr int BM = 256, BK = 64, HALF = 128, HTB = HALF * BK * 2  , STAGE_BYTES = 8 * HTB, NXCD = 8, WGM = 8;

__host__ __device__ __forceinline__ int lds_byte(int r, int c) { const int st = (r >> 4) * 2 + (c >> 5), rr = r & 15, cc = c & 31, ob = rr * 64 + cc * 2; return st * 1024 + (ob ^ (((ob >> 9) & 1) << 5)); }
__host__ __device__ __forceinline__ void stage_rc(int b, int& R, int& C) { const int st = b / 1024, sb = b % 1024, swz = sb ^ (((sb >> 9) & 1) << 5); R = (st >> 1) * 16 + swz / 64; C = (st & 1) * 32 + (swz % 64) / 2; }
__host__ __device__ __forceinline__ int perm32(int rho) { const int n = rho >> 4, i = rho & 15; return 8 * (i >> 2) + 4 * n + (i & 3); }

struct Unit { int pm, pn; };
struct Gemm { const bf16_t* A; const bf16_t* Bt; int M, N, K; };

struct StaticOrder {
    int nM, nN, nwg, G, c;
    __host__ __device__ void init(int M, int N, int G_, int c_) { nM = M / BM; nN = N / BM; nwg = nM * nN; G = G_; c = c_; }
    __host__ __device__ bool next(int i, Unit& u) const {
        const long L = (long)i * G + c; if (L >= nwg) return false;
        int wgid = (int)L; { const int q = nwg / NXCD, r = nwg % NXCD, xcd = wgid % NXCD, off = wgid / NXCD; wgid = (xcd < r ? xcd * (q + 1) : r * (q + 1) + (xcd - r) * q) + off; }
        const int nig = WGM * nN, gid = wgid / nig, fm = gid * WGM, gsz = (nM - fm) < WGM ? (nM - fm) : WGM;
        u.pm = fm + ((wgid % nig) % gsz); u.pn = (wgid % nig) / gsz; return true;
    }
    __device__ __forceinline__ void a_ready(const Unit&) const {}
    __device__ __forceinline__ void done(const Unit&) const {}
};
__device__ __forceinline__ unsigned cvt_pk_bf16(float lo, float hi) { unsigned r; asm volatile("v_cvt_pk_bf16_f32 %0, %1, %2" : "=v"(r) : "v"(lo), "v"(hi)); return r; }
typedef float f32x2 __attribute__((ext_vector_type(2)));
template <int ACT  > struct EpiBf16S {
    static constexpr bool PERM = true, AFTER_DRAIN = false;
    bf16_t* O; int ldc;
    __device__ __forceinline__ void operator()(const f32x4 (&acc)[2][2][4][2], const Unit& u, int wr, int wc, int fr, int fq) const {
        const int row0 = u.pm * BM + wr * 64 + fr, col0 = u.pn * BM + wc * 32 + 8 * fq;
#pragma unroll
        for (int ai = 0; ai < 2; ++ai)
#pragma unroll
            for (int m = 0; m < 4; ++m) { bf16_t* rowp = O + (size_t)(row0 + ai * HALF + m * 16) * ldc + col0;
#pragma unroll
                for (int bj = 0; bj < 2; ++bj) { f32x4 v0 = acc[ai][bj][m][0], v1 = acc[ai][bj][m][1];
                    if (ACT == 1) {
#pragma unroll
                        for (int e = 0; e < 4; ++e) { const float a = fmaxf(v0[e], 0.f), b = fmaxf(v1[e], 0.f); v0[e] = a * a; v1[e] = b * b; } }
                    u32x4 w; w.x = cvt_pk_bf16(v0[0], v0[1]); w.y = cvt_pk_bf16(v0[2], v0[3]); w.z = cvt_pk_bf16(v1[0], v1[1]); w.w = cvt_pk_bf16(v1[2], v1[3]);
                    *(u32x4*)(rowp + bj * HALF) = w; } }
    }
};
struct EpiResGate {
    static constexpr bool PERM = false, AFTER_DRAIN = false;
    const float* base; float* out; int ldc; const float* gate; int gate_bstride; int rows_per_batch;
    __device__ __forceinline__ void operator()(const f32x4 (&acc)[2][2][4][2], const Unit& u, int wr, int wc, int fr, int fq) const {
        const int row0 = u.pm * BM + wr * 64 + fr, col0 = u.pn * BM + wc * 32 + 4 * fq;
        const float* gp = gate + (size_t)((u.pm * BM) / rows_per_batch) * gate_bstride + col0;
        f32x4 gv[2][2];
#pragma unroll
        for (int bj = 0; bj < 2; ++bj)
#pragma unroll
            for (int n = 0; n < 2; ++n) gv[bj][n] = *(const f32x4*)(gp + bj * HALF + n * 16);
#pragma unroll
        for (int ai = 0; ai < 2; ++ai)
#pragma unroll
            for (int m = 0; m < 4; ++m) { const size_t off = (size_t)(row0 + ai * HALF + m * 16) * ldc + col0;
#pragma unroll
                for (int bj = 0; bj < 2; ++bj)
#pragma unroll
                    for (int n = 0; n < 2; ++n) { const f32x4 bs = *(const f32x4*)(base + off + bj * HALF + n * 16); *(f32x4*)(out + off + bj * HALF + n * 16) = bs + gv[bj][n] * acc[ai][bj][m][n]; } }
    }
};
struct EpiQKV {
    static constexpr bool PERM = true, AFTER_DRAIN = false;
    bf16_t* O; int ldc; bf16_t* VT; int vmod, vres; int S_;
    __device__ __forceinline__ void operator()(const f32x4 (&acc)[2][2][4][2], const Unit& u, int wr, int wc, int fr, int fq) const {
        const int row0 = u.pm * BM + wr * 64 + fr;
        if (u.pn % vmod == vres) {
            const int gi = u.pn / vmod, dsh = 2 * gi, b = (u.pm * BM) / S_;
            bf16_t* vb = VT + ((size_t)gi * 8 + b) * 4 * 64 * S_;
            const unsigned lane_off = (unsigned)((wc >> 1) * (64 * S_) + ((wc & 1) * 32 + 8 * fq) * 32);
#pragma unroll
            for (int ai = 0; ai < 2; ++ai)
#pragma unroll
                for (int m = 0; m < 4; ++m) { const int t = (row0 + ai * HALF + m * 16) & (S_ - 1); const int uu = t >> dsh, rr = t & ((1 << dsh) - 1);
                    const unsigned voff = lane_off + (unsigned)(rr * ((S_ >> dsh) * 64) + (uu >> 5) * 2048 + (uu & 31));
#pragma unroll
                    for (int bj = 0; bj < 2; ++bj)
#pragma unroll
                        for (int n = 0; n < 2; ++n)
#pragma unroll
                            for (int e = 0; e < 4; ++e) { bf16_t* vu = vb + (size_t)(bj * 2) * (64 * S_) + (4 * n + e) * 32;
                                const unsigned w = cvt_pk_bf16(acc[ai][bj][m][n][e], 0.f); vu[voff] = (bf16_t)(w & 0xffffu); }
                    asm volatile("" ::: "memory"); }
            return;
        }
        const int col0 = u.pn * BM + wc * 32 + 8 * fq;
#pragma unroll
        for (int ai = 0; ai < 2; ++ai)
#pragma unroll
            for (int m = 0; m < 4; ++m) { bf16_t* rowp = O + (size_t)(row0 + ai * HALF + m * 16) * ldc + col0;
#pragma unroll
                for (int bj = 0; bj < 2; ++bj) { const f32x4 v0 = acc[ai][bj][m][0], v1 = acc[ai][bj][m][1];
                    u32x4 w; w.x = cvt_pk_bf16(v0[0], v0[1]); w.y = cvt_pk_bf16(v0[2], v0[3]); w.z = cvt_pk_bf16(v1[0], v1[1]); w.w = cvt_pk_bf16(v1[2], v1[3]);
                    *(u32x4*)(rowp + bj * HALF) = w; } }
    }
};
struct EpiKVd {
    static constexpr bool PERM = true, AFTER_DRAIN = false;
    bf16_t* O; int ldc; bf16_t* VT; int S_;
    __device__ __forceinline__ void operator()(const f32x4 (&acc)[2][2][4][2], const Unit& u, int wr, int wc, int fr, int fq) const {
        const int row0 = u.pm * BM + wr * 64 + fr, col0 = u.pn * BM + wc * 32 + 8 * fq;
#pragma unroll
        for (int ai = 0; ai < 2; ++ai)
#pragma unroll
            for (int m = 0; m < 4; ++m) { const int r = row0 + ai * HALF + m * 16;
                const f32x4 v0 = acc[ai][0][m][0], v1 = acc[ai][0][m][1];
                u32x4 w; w.x = cvt_pk_bf16(v0[0], v0[1]); w.y = cvt_pk_bf16(v0[2], v0[3]); w.z = cvt_pk_bf16(v1[0], v1[1]); w.w = cvt_pk_bf16(v1[2], v1[3]);
                *(u32x4*)(O + (size_t)r * ldc + col0) = w; }
        asm volatile("" ::: "memory");
        const int b = (u.pm * BM) / S_;
        bf16_t* vb = VT + (size_t)b * 128 * S_;
#pragma unroll
        for (int ai = 0; ai < 2; ++ai)
#pragma unroll
            for (int m = 0; m < 4; ++m) { const int t = (row0 + ai * HALF + m * 16) & (S_ - 1);
                const unsigned voff = (unsigned)((t >> 5) * 4096 + (wc * 32 + 8 * fq) * 32 + (t & 31));
#pragma unroll
                for (int n = 0; n < 2; ++n)
#pragma unroll
                    for (int e = 0; e < 4; ++e) { const unsigned w = cvt_pk_bf16(acc[ai][1][m][n][e], 0.f); vb[voff + (4 * n + e) * 32] = (bf16_t)(w & 0xffffu); }
                asm volatile("" ::: "memory"); }
    }
};
struct EpiQKVold {
    static constexpr bool PERM = true, AFTER_DRAIN = false;
    bf16_t* O; int ldc; bf16_t* VT; int vmod, vres; int S_;
    __device__ __forceinline__ void operator()(const f32x4 (&acc)[2][2][4][2], const Unit& u, int wr, int wc, int fr, int fq) const {
        const int row0 = u.pm * BM + wr * 64 + fr;
        if (u.pn % vmod == vres) {
            const int gi = u.pn / vmod, dsh = 2 * gi, b = (u.pm * BM) / S_;
            bf16_t* vb = VT + ((size_t)gi * 8 + b) * 4 * 64 * S_;
            const unsigned lane_off = (unsigned)((wc * 32 + 8 * fq) * S_);
#pragma unroll
            for (int ai = 0; ai < 2; ++ai)
#pragma unroll
                for (int m = 0; m < 4; ++m) { const int t = (row0 + ai * HALF + m * 16) & (S_ - 1); const unsigned voff = lane_off + (unsigned)((t & ((1 << dsh) - 1)) * (S_ >> dsh) + (t >> dsh));
#pragma unroll
                    for (int bj = 0; bj < 2; ++bj)
#pragma unroll
                        for (int n = 0; n < 2; ++n)
#pragma unroll
                            for (int e = 0; e < 4; ++e) { bf16_t* vu = vb + (size_t)(bj * HALF + 4 * n + e) * S_;
                                const unsigned w = cvt_pk_bf16(acc[ai][bj][m][n][e], 0.f); vu[voff] = (bf16_t)(w & 0xffffu); }
                    asm volatile("" ::: "memory"); }
            return;
        }
        const int col0 = u.pn * BM + wc * 32 + 8 * fq;
#pragma unroll
        for (int ai = 0; ai < 2; ++ai)
#pragma unroll
            for (int m = 0; m < 4; ++m) { bf16_t* rowp = O + (size_t)(row0 + ai * HALF + m * 16) * ldc + col0;
#pragma unroll
                for (int bj = 0; bj < 2; ++bj) { const f32x4 v0 = acc[ai][bj][m][0], v1 = acc[ai][bj][m][1];
                    u32x4 w; w.x = cvt_pk_bf16(v0[0], v0[1]); w.y = cvt_pk_bf16(v0[2], v0[3]); w.z = cvt_pk_bf16(v1[0], v1[1]); w.w = cvt_pk_bf16(v1[2], v1[3]);
                    *(u32x4*)(rowp + bj * HALF) = w; } }
    }
};
template <class Epi, class Sched, bool ALIGN_EPI = false, bool SP2 = false>
__device__ __forceinline__ void gemm_phase(PG8_LAS unsigned char* lds, const Gemm g, const Sched& S, const Epi& E, const int wave_) {
    int ln_; asm volatile("v_mbcnt_lo_u32_b32 %0, -1, 0\n\tv_mbcnt_hi_u32_b32 %0, -1, %0" : "=v"(ln_)); const int tid_ = wave_ * 64 + ln_;
    const int tid = tid_, wid = __builtin_amdgcn_readfirstlane(tid >> 6), lane = tid & 63, wr = wid >> 2, wc = wid & 3, fr = lane & 15, fq = lane >> 4;
    const int K = g.K, nt = K / BK;
    unsigned voffA[2], voffB[2];
#pragma unroll
    for (int i = 0; i < 2; ++i) { int R, C; stage_rc(tid * 16 + i * 8192, R, C); const int Rb = Epi::PERM ? ((R & ~31) + perm32(R & 31)) : R;
        voffA[i] = (unsigned)(R * K + C) * 2u; voffB[i] = (unsigned)(Rb * K + C) * 2u; }
    const size_t kstep = (size_t)(BK * 2);
    const size_t hstep = (size_t)HALF * K * 2;
    const size_t tstep = 2 * hstep;
    const unsigned ldsw = (unsigned)wid * 1024u;
    const int aoff = lds_byte(wr * 64 + fr, fq * 8), boff = lds_byte(wc * 32 + fr, fq * 8);
#define PG8_SA(b, h) (((b) * 2 + (h)) * HTB)
#define PG8_SB(b, h) ((4 + (b) * 2 + (h)) * HTB)
#define PG8_STAGE(bufoff, gbase, voff) do { _Pragma("unroll") for (int _i = 0; _i < 2; ++_i) \
        __builtin_amdgcn_global_load_lds((const unsigned*)((const char*)(gbase) + (voff)[_i]), (PG8_LAS unsigned*)(lds + (bufoff) + ldsw + _i * 8192), 16, 0, 0); } while (0)
#define PG8_LDA(dst, b, h) do { _Pragma("unroll") for (int m = 0; m < 4; ++m) _Pragma("unroll") for (int k = 0; k < 2; ++k) dst[m][k] = *(const PG8_LAS bf16x8*)(lds + PG8_SA(b, h) + aoff + m * 2048 + k * 1024); } while (0)
#define PG8_LDB(dst, b, h) do { _Pragma("unroll") for (int n = 0; n < 2; ++n) _Pragma("unroll") for (int k = 0; k < 2; ++k) dst[n][k] = *(const PG8_LAS bf16x8*)(lds + PG8_SB(b, h) + boff + n * 2048 + k * 1024); } while (0)
#define PG8_MMA(ai, bj, At, Bt) do { __builtin_amdgcn_s_setprio(1); _Pragma("unroll") for (int m = 0; m < 4; ++m) _Pragma("unroll") for (int n = 0; n < 2; ++n) _Pragma("unroll") for (int k = 0; k < 2; ++k) \
        acc[ai][bj][m][n] = __builtin_amdgcn_mfma_f32_16x16x32_bf16(Bt[n][k], At[m][k], acc[ai][bj][m][n], 0, 0, 0); __builtin_amdgcn_s_setprio(0); } while (0)
#define PG8_WAIT_V(n) asm volatile("s_waitcnt vmcnt(" #n ")" ::: "memory")
#define PG8_WAIT_L(n) asm volatile("s_waitcnt lgkmcnt(" #n ")" ::: "memory")
#define PG8_BAR __builtin_amdgcn_s_barrier()
#define PG8_SCHED __builtin_amdgcn_sched_barrier(0)
    Unit cur, nxt; int ui = 0;
    if (!S.next(0, cur)) return;
    f32x4 acc[2][2][4][2];
#pragma unroll
    for (int a = 0; a < 2; ++a)
#pragma unroll
        for (int b = 0; b < 2; ++b)
#pragma unroll
            for (int m = 0; m < 4; ++m)
#pragma unroll
                for (int n = 0; n < 2; ++n) acc[a][b][m][n] = (f32x4){0.f, 0.f, 0.f, 0.f};
    bf16x8 At[4][2], B0[2][2], B1[2][2];
    const char* cA = (const char*)g.A + (size_t)cur.pm * tstep; const char* cB = (const char*)g.Bt + (size_t)cur.pn * tstep;
    S.a_ready(cur);
    if constexpr (SP2) {
        PG8_STAGE(PG8_SB(0, 0), cB, voffB); PG8_STAGE(PG8_SB(0, 1), cB + hstep, voffB); PG8_STAGE(PG8_SA(0, 0), cA, voffA); PG8_STAGE(PG8_SA(0, 1), cA + hstep, voffA);
        if (wr == 1) PG8_BAR;
        PG8_WAIT_V(2); PG8_BAR;
        PG8_STAGE(PG8_SB(1, 0), cB + kstep, voffB); PG8_STAGE(PG8_SA(1, 0), cA + kstep, voffA); PG8_STAGE(PG8_SB(1, 1), cB + hstep + kstep, voffB);
        PG8_WAIT_V(6); PG8_BAR;
    } else {
        PG8_STAGE(PG8_SB(0, 0), cB, voffB); PG8_STAGE(PG8_SA(0, 0), cA, voffA); PG8_STAGE(PG8_SB(0, 1), cB + hstep, voffB); PG8_STAGE(PG8_SA(0, 1), cA + hstep, voffA);
        if (wr == 1) PG8_BAR;
        PG8_WAIT_V(4); PG8_BAR;
        PG8_STAGE(PG8_SB(1, 0), cB + kstep, voffB); PG8_STAGE(PG8_SA(1, 0), cA + kstep, voffA); PG8_STAGE(PG8_SB(1, 1), cB + hstep + kstep, voffB);
        PG8_WAIT_V(6); PG8_BAR;
    }
    for (;;) {
        const bool has_next = S.next(ui + 1, nxt);
        const char* nA = has_next ? (const char*)g.A + (size_t)nxt.pm * tstep : cA; const char* nB = has_next ? (const char*)g.Bt + (size_t)nxt.pn * tstep : cB;
#pragma unroll 1
        for (int t = 0; t < nt; t += 2) {
            const bool last = (t == nt - 2);
            const char* a1 = cA + (size_t)(t + 1) * kstep;
            const char* a2 = last ? nA : cA + (size_t)(t + 2) * kstep; const char* b2 = last ? nB : cB + (size_t)(t + 2) * kstep;
            const char* a3 = a2 + kstep; const char* b3 = b2 + kstep;
            if (last && has_next) S.a_ready(nxt);
            if constexpr (SP2) {
            PG8_LDB(B0, 0, 0); PG8_LDB(B1, 0, 1); PG8_SCHED; PG8_LDA(At, 0, 0); PG8_STAGE(PG8_SA(1, 1), a1 + hstep, voffA);
            PG8_WAIT_V(8); PG8_WAIT_L(0); PG8_BAR; PG8_MMA(0, 0, At, B0); PG8_MMA(0, 1, At, B1); PG8_BAR; PG8_SCHED;
            PG8_LDA(At, 0, 1); PG8_STAGE(PG8_SB(0, 0), b2, voffB); PG8_STAGE(PG8_SB(0, 1), b2 + hstep, voffB); PG8_STAGE(PG8_SA(0, 0), a2, voffA);
            PG8_WAIT_V(8); PG8_WAIT_L(0); PG8_BAR; PG8_MMA(1, 0, At, B0); PG8_MMA(1, 1, At, B1); PG8_BAR; PG8_SCHED;
            PG8_LDB(B0, 1, 0); PG8_LDB(B1, 1, 1); PG8_SCHED; PG8_LDA(At, 1, 0); PG8_STAGE(PG8_SA(0, 1), a2 + hstep, voffA);
            PG8_WAIT_V(8); PG8_WAIT_L(0); PG8_BAR; PG8_MMA(0, 0, At, B0); PG8_MMA(0, 1, At, B1); PG8_BAR; PG8_SCHED;
            PG8_LDA(At, 1, 1); PG8_STAGE(PG8_SB(1, 0), b3, voffB); PG8_STAGE(PG8_SB(1, 1), b3 + hstep, voffB); PG8_STAGE(PG8_SA(1, 0), a3, voffA);
            PG8_WAIT_V(8); PG8_WAIT_L(0); PG8_BAR; PG8_MMA(1, 0, At, B0); PG8_MMA(1, 1, At, B1); PG8_BAR; PG8_SCHED;
            } else {
            PG8_LDB(B0, 0, 0); PG8_SCHED; PG8_LDA(At, 0, 0); PG8_STAGE(PG8_SA(1, 1), a1 + hstep, voffA);
            PG8_WAIT_L(8); PG8_BAR; PG8_WAIT_L(0); PG8_MMA(0, 0, At, B0); PG8_BAR; PG8_SCHED;
            PG8_LDB(B1, 0, 1); PG8_STAGE(PG8_SB(0, 0), b2, voffB);
            PG8_BAR; PG8_WAIT_L(0); PG8_MMA(0, 1, At, B1); PG8_BAR;
            PG8_LDA(At, 0, 1); PG8_STAGE(PG8_SA(0, 0), a2, voffA);
            PG8_BAR; PG8_WAIT_L(0); PG8_MMA(1, 0, At, B0); PG8_BAR; PG8_SCHED;
            PG8_STAGE(PG8_SB(0, 1), b2 + hstep, voffB);
            PG8_WAIT_V(6); PG8_BAR; PG8_MMA(1, 1, At, B1); PG8_BAR;
            PG8_LDB(B0, 1, 0); PG8_SCHED; PG8_LDA(At, 1, 0); PG8_STAGE(PG8_SA(0, 1), a2 + hstep, voffA);
            PG8_WAIT_L(8); PG8_BAR; PG8_WAIT_L(0); PG8_MMA(0, 0, At, B0); PG8_BAR; PG8_SCHED;
            PG8_LDB(B1, 1, 1); PG8_STAGE(PG8_SB(1, 0), b3, voffB);
            PG8_BAR; PG8_WAIT_L(0); PG8_MMA(0, 1, At, B1); PG8_BAR;
            PG8_LDA(At, 1, 1); PG8_STAGE(PG8_SA(1, 0), a3, voffA);
            PG8_BAR; PG8_WAIT_L(0); PG8_MMA(1, 0, At, B0); PG8_BAR; PG8_SCHED;
            PG8_STAGE(PG8_SB(1, 1), b3 + hstep, voffB);
            PG8_WAIT_V(6); PG8_BAR; PG8_MMA(1, 1, At, B1); PG8_BAR;
            }
        }
        if constexpr (ALIGN_EPI) { if (wr == 0) PG8_BAR; }
        if constexpr (!Epi::AFTER_DRAIN) { E(acc, cur, wr, wc, fr, fq); S.done(cur); }
        if (!has_next) break;
#pragma unroll
        for (int a = 0; a < 2; ++a)
#pragma unroll
            for (int b = 0; b < 2; ++b)
#pragma unroll
                for (int m = 0; m < 4; ++m)
#pragma unroll
                    for (int n = 0; n < 2; ++n) acc[a][b][m][n] = (f32x4){0.f, 0.f, 0.f, 0.f};
        cur = nxt; cA = nA; cB = nB; ++ui;
        if constexpr (ALIGN_EPI) { if (wr == 1) PG8_BAR; }
    }
    PG8_WAIT_V(0);
    if constexpr (!ALIGN_EPI) { if (wr == 0) PG8_BAR; }
    PG8_BAR;
    if constexpr (Epi::AFTER_DRAIN) { E.fused(acc, cur, wr, wc, fr, fq, lds, wid, lane); S.done(cur); }
#undef PG8_SA
#undef PG8_SB
#undef PG8_STAGE
#undef PG8_LDA
#undef PG8_LDB
#undef PG8_MMA
#undef PG8_WAIT_V
#undef PG8_WAIT_L
#undef PG8_BAR
#undef PG8_SCHED
}
}
constexpr int NWAVES = 8, NT = NWAVES * 64;
constexpr int BATCH = 8, S = 2048, D = 2048, M = BATCH * S, FF = 8192, DEPTH = 4;
constexpr int SWA_IN = 2560, DSA_INP = 1024  , DSA_IN_SRC = 848, DIL_IN = 4608, DSA_QQ = 3072;
constexpr float EPS = 1e-6f;
constexpr size_t MiB = 1u << 20;
constexpr size_t WS_CTL = 0, CTL_ZERO_BYTES = 1 * MiB;
constexpr size_t WS_MOD = 1 * MiB;
constexpr size_t WS_W1T = 4 * MiB, WS_W2T = 132 * MiB;
constexpr size_t WS_SWA_IN_T = 260 * MiB, WS_SWA_OUT_T = 280 * MiB;
constexpr size_t WS_DSA_IN_T = 296 * MiB, WS_DSA_UQ_T = 300 * MiB, WS_DSA_UKV_T = 303 * MiB, WS_DSA_OUT_T = 304 * MiB;
constexpr size_t WS_DIL_IN_T = 312 * MiB, WS_DIL_OUT_T = 330 * MiB;
constexpr size_t WS_H = 334 * MiB;
constexpr size_t WS_BIG = 398 * MiB;
constexpr size_t WS_PROJ = WS_BIG;
constexpr size_t WS_O = WS_BIG + 192 * MiB;
constexpr size_t WS_LAT = WS_BIG, WS_QL = WS_BIG + 32 * MiB, WS_KVL = WS_BIG + 48 * MiB, WS_KV = WS_BIG + 56 * MiB, WS_IDX = WS_BIG + 64 * MiB, WS_NSEL = WS_BIG + 72 * MiB, WS_QQ = WS_BIG + 80 * MiB;
constexpr size_t WS_VT = WS_BIG + 144 * MiB, WS_LSE = WS_BIG + 170 * MiB;
constexpr size_t WS_VTD = WS_BIG + 64 * MiB;
constexpr size_t WS_KT = 654 * MiB, WS_KI = 680 * MiB;
constexpr size_t WS_END = 684 * MiB;
constexpr int CW_BAR = 4096;
constexpr int RING_OFF = 0, RING_BYTES = 131072;
constexpr int LDSCTL_OFF = RING_BYTES, MISC_OFF = LDSCTL_OFF + 320;
constexpr int LDS_BYTES = 147456;

#define GAS __attribute__((address_space(1)))
#define LAS __attribute__((address_space(3)))
typedef unsigned short bf16;
typedef unsigned v4u __attribute__((ext_vector_type(4)));
typedef unsigned v2u __attribute__((ext_vector_type(2)));
typedef float f32x4 __attribute__((ext_vector_type(4)));
#define LDS_WAIT() asm volatile("s_waitcnt lgkmcnt(0)" ::: "memory")
#define VM_WAIT() asm volatile("s_waitcnt vmcnt(0)" ::: "memory")
__device__ __forceinline__ unsigned f2bf(float f) { unsigned u = __builtin_bit_cast(unsigned, f); return (u + 0x7fffu + ((u >> 16) & 1u)) >> 16; }
__device__ __forceinline__ unsigned pk2(float lo, float hi) { return f2bf(lo) | (f2bf(hi) << 16); }
__device__ __forceinline__ float bflo(unsigned w) { return __uint_as_float(w << 16); }
__device__ __forceinline__ float bfhi(unsigned w) { return __uint_as_float(w & 0xffff0000u); }
__device__ __forceinline__ float bf2f(bf16 v) { return __uint_as_float((unsigned)v << 16); }
__device__ __forceinline__ void unpack8(const v4u w, float* f) { f[0] = bflo(w.x); f[1] = bfhi(w.x); f[2] = bflo(w.y); f[3] = bfhi(w.y); f[4] = bflo(w.z); f[5] = bfhi(w.z); f[6] = bflo(w.w); f[7] = bfhi(w.w); }
__device__ __forceinline__ float wave_sum(float v) {
#pragma unroll
    for (int o = 1; o < 64; o <<= 1) v += __shfl_xor(v, o);
    return v;
}
__device__ __forceinline__ float wave_max(float v) {
#pragma unroll
    for (int o = 1; o < 64; o <<= 1) v = fmaxf(v, __shfl_xor(v, o));
    return v;
}
__device__ __forceinline__ int opq(int v) { asm volatile("" : "+v"(v)); return v; }
__device__ __forceinline__ int kperm5(int i) { return (i & ~12) | ((i & 4) << 1) | ((i & 8) >> 1); }
__device__ __forceinline__ int lane_id() { int x; asm volatile("v_mbcnt_lo_u32_b32 %0, -1, 0\n\tv_mbcnt_hi_u32_b32 %0, -1, %0" : "=v"(x)); return x; }
__device__ __forceinline__ void st_wt16(bf16* p, v4u v) { asm volatile("global_store_dwordx4 %0, %1, off sc0 sc1" :: "v"((GAS v4u*)p), "v"(v) : "memory"); }
#define XB_TMO      128
#define XB_XCNT(j)  (256  + 64 * (j))
#define XB_XSUB(j)  (1280 + 64 * (j))
#define XB_XGEN(j)  (2304 + 64 * (j))
#define XB_TOP      3328
#define XB_TOPGEN   3392
#define XCD_BAR_WORDS 3456
#define XB_SPIN_CAP (1u << 18)

__device__ __forceinline__ unsigned xb_ld(unsigned* p)              { return __hip_atomic_load(p, __ATOMIC_RELAXED, __HIP_MEMORY_SCOPE_AGENT); }
__device__ __forceinline__ unsigned xb_add(unsigned* p, unsigned v) { return __hip_atomic_fetch_add(p, v, __ATOMIC_RELAXED, __HIP_MEMORY_SCOPE_AGENT); }
__device__ __forceinline__ unsigned xb_xcc_id() { return (unsigned)__builtin_amdgcn_s_getreg((3 << 11) | 20) & 0xFu; }
#define XB_SPIN(cond, bar) do { unsigned _sp = 0; while (cond) { __builtin_amdgcn_s_sleep(1); \
    if ((++_sp & 255u) == 0u) { if (xb_ld(&(bar)[XB_TMO])) break; if (_sp > XB_SPIN_CAP) { atomicAdd(&(bar)[XB_TMO], 1u); break; } } } } while (0)

struct XcdBarrier {
    unsigned* bar; unsigned x; int w;
    volatile LAS unsigned* st;
};

__device__ __forceinline__ XcdBarrier xcd_barrier_post(unsigned* bar, volatile LAS unsigned* st, int wave) {
    XcdBarrier b; b.bar = bar; b.x = xb_xcc_id(); b.st = st; b.w = wave;
    if (wave == 0 && lane_id() == 0) (void)xb_add(&bar[XB_XCNT(b.x)], 1u);
    return b;
}
__device__ __forceinline__ void xcd_barrier_complete(unsigned* bar, unsigned x, unsigned& nloc, unsigned& nx) {
    const unsigned G = gridDim.x * gridDim.y * gridDim.z;
    unsigned sum, cnt, mine, sp = 0u;
    for (;;) {
        sum = 0u; cnt = 0u; mine = 0u;
#pragma unroll
        for (unsigned j = 0; j < 16; ++j) { const unsigned c = xb_ld(&bar[XB_XCNT(j)]); sum += c; cnt += (c > 0u) ? 1u : 0u; mine = (j == x) ? c : mine; }
        if (sum == G) break;
        __builtin_amdgcn_s_sleep(1);
        if ((++sp & 255u) == 0u) { if (xb_ld(&bar[XB_TMO])) break; if (sp > XB_SPIN_CAP) { atomicAdd(&bar[XB_TMO], 1u); break; } }
    }
    nloc = mine > 0u ? mine : 1u; nx = cnt > 0u ? cnt : 1u;
}

__device__ __forceinline__ void xcd_barrier(const XcdBarrier& b) {
    asm volatile("s_waitcnt vmcnt(0)" ::: "memory");
    __syncthreads();
    if (b.w == 0 && lane_id() == 0) {
        unsigned* bar = b.bar;
        __builtin_amdgcn_s_waitcnt(0);
        unsigned nloc = b.st[0], nx = b.st[1];
        if (nloc == 0u) { xcd_barrier_complete(bar, b.x, nloc, nx); b.st[0] = nloc; b.st[1] = nx; }
        const unsigned old = xb_add(&bar[XB_XSUB(b.x)], 1u);
        const unsigned gen = old / nloc;
        if (old + 1u == (gen + 1u) * nloc) {
            __builtin_amdgcn_fence(__ATOMIC_RELEASE, "agent");
            asm volatile("s_waitcnt vmcnt(0)" ::: "memory");
            const unsigned og = xb_add(&bar[XB_TOP], 1u);
            const unsigned tg = og / nx;
            if (og + 1u == (tg + 1u) * nx) xb_add(&bar[XB_TOPGEN], 1u);
            else XB_SPIN(xb_ld(&bar[XB_TOPGEN]) == tg, bar);
            __builtin_amdgcn_fence(__ATOMIC_ACQUIRE, "agent");
            xb_add(&bar[XB_XGEN(b.x)], 1u);
            asm volatile("s_waitcnt vmcnt(0)" ::: "memory");
        } else {
            XB_SPIN(xb_ld(&bar[XB_XGEN(b.x)]) == gen, bar);
            __builtin_amdgcn_fence(__ATOMIC_ACQUIRE, "agent");
            asm volatile("s_waitcnt vmcnt(0)" ::: "memory");
        }
    }
    __syncthreads();
}
struct Frame {
    LAS unsigned char* lds;
    int tid, lane, wave, G, gw, NGW;
};

__device__ __forceinline__ void p0_ada(const Frame& F0, const float* c, const float* ada_w, const float* ada_b, float* mod) {
    Frame F = F0; F.lane = opq(lane_id()); F.tid = F0.wave * 64 + F.lane;
    LAS float* cond = (LAS float*)(F.lds + RING_OFF);
    LAS float* red = (LAS float*)(F.lds + RING_OFF + 65536);
    for (int i = F.tid; i < 8 * 2048; i += NT) { const int b = i >> 11, k = i & 2047; const float v = c[i]; cond[k * 8 + b] = v / (1.f + __expf(-v)); }
    __syncthreads();
    constexpr int NSLAB = DEPTH * 64;
    for (int slab = blockIdx.x; slab < NSLAB; slab += F.G) {
        const int layer = slab >> 6, col0 = (slab & 63) * 192;
        const float* W = ada_w + (size_t)layer * 2048 * 12288 + col0 + F.lane;
        float acc[3][8];
#pragma unroll
        for (int j = 0; j < 3; ++j)
#pragma unroll
            for (int b = 0; b < 8; ++b) acc[j][b] = 0.f;
        const int k0 = F.wave * 256;
        for (int k = k0; k < k0 + 256; k += 8) {
            float w[8][3];
#pragma unroll
            for (int kk = 0; kk < 8; ++kk)
#pragma unroll
                for (int j = 0; j < 3; ++j) w[kk][j] = W[(size_t)(k + kk) * 12288 + 64 * j];
#pragma unroll
            for (int kk = 0; kk < 8; ++kk) {
                const f32x4 c0 = *(const LAS f32x4*)(cond + (k + kk) * 8), c1 = *(const LAS f32x4*)(cond + (k + kk) * 8 + 4);
#pragma unroll
                for (int j = 0; j < 3; ++j) {
                    acc[j][0] += w[kk][j] * c0[0]; acc[j][1] += w[kk][j] * c0[1]; acc[j][2] += w[kk][j] * c0[2]; acc[j][3] += w[kk][j] * c0[3];
                    acc[j][4] += w[kk][j] * c1[0]; acc[j][5] += w[kk][j] * c1[1]; acc[j][6] += w[kk][j] * c1[2]; acc[j][7] += w[kk][j] * c1[3]; }
            }
        }
#pragma unroll
        for (int j = 0; j < 3; ++j)
#pragma unroll
            for (int b = 0; b < 8; ++b) red[(F.wave * 8 + b) * 192 + j * 64 + F.lane] = acc[j][b];
        __syncthreads();
        for (int o = F.tid; o < 8 * 192; o += NT) { const int b = o / 192, cc = o % 192; float s = 0.f;
#pragma unroll
            for (int w = 0; w < 8; ++w) s += red[(w * 8 + b) * 192 + cc];
            mod[(size_t)(layer * 8 + b) * 12288 + col0 + cc] = s + ada_b[layer * 12288 + col0 + cc]; }
        __syncthreads();
    }
}

__device__ __forceinline__ void p0_transpose_item(const float* W, int K, int Nsrc, int Npad, bf16* WT, int row_off, LAS float* scr, int item, int lane) {
    const int nblk = Npad / 32, kb = item / nblk, nb = item % nblk, k0 = 64 * kb, n0 = 32 * nb;
    const int nc = n0 + (lane & 31); const bool ok = nc < Nsrc;
    float wreg[32];
    const float* wp = W + (size_t)(k0 + (lane >> 5)) * Nsrc + (ok ? nc : 0);
#pragma unroll
    for (int i = 0; i < 32; ++i) wreg[i] = wp[(size_t)(2 * i) * Nsrc];
#pragma unroll
    for (int i = 0; i < 32; ++i) scr[(2 * i + (lane >> 5)) * 33 + (lane & 31)] = ok ? wreg[i] : 0.f;
    LDS_WAIT(); asm volatile("" ::: "memory");
    const int cch = lane & 7;
#pragma unroll
    for (int j = 0; j < 4; ++j) { const int n = (lane >> 3) + 8 * j; const LAS float* s = scr + (8 * cch) * 33 + n;
        v4u o; o.x = pk2(s[0 * 33], s[1 * 33]); o.y = pk2(s[2 * 33], s[3 * 33]); o.z = pk2(s[4 * 33], s[5 * 33]); o.w = pk2(s[6 * 33], s[7 * 33]);
        *(GAS v4u*)(WT + (size_t)(row_off + n0 + n) * K + k0 + 8 * cch) = o; }
    LDS_WAIT(); asm volatile("" ::: "memory");
}
struct TJob { const float* src; bf16* dst; int K, Nsrc, Npad, row_off, items; };
__device__ __forceinline__ void p0_weights(const Frame& F0, const float* const* in, unsigned char* ws) {
    Frame F = F0; F.lane = opq(lane_id()); F.tid = F0.wave * 64 + F.lane;
    LAS float* scr = (LAS float*)(F.lds + RING_OFF + F.wave * 16384);
    constexpr int NJOB = 19;
    for (int it = F.gw; ; it += F.NGW) {
        int r = it; TJob jb; bool found = false;
#pragma unroll
        for (int q = 0; q < NJOB; ++q) {
            TJob t;
            if (q < 4)       t = TJob{in[6] + (size_t)q * D * FF, (bf16*)(ws + WS_W1T) + (size_t)q * FF * D, D, FF, FF, 0, (D / 64) * (FF / 32)};
            else if (q < 8)  t = TJob{in[7] + (size_t)(q - 4) * FF * D, (bf16*)(ws + WS_W2T) + (size_t)(q - 4) * D * FF, FF, D, D, 0, (FF / 64) * (D / 32)};
            else if (q < 10) t = TJob{in[8] + (size_t)(q - 8) * D * SWA_IN, (bf16*)(ws + WS_SWA_IN_T) + (size_t)(q - 8) * SWA_IN * D, D, SWA_IN, SWA_IN, 0, (D / 64) * (SWA_IN / 32)};
            else if (q < 12) t = TJob{in[12] + (size_t)(q - 10) * D * D, (bf16*)(ws + WS_SWA_OUT_T) + (size_t)(q - 10) * D * D, D, D, D, 0, (D / 64) * (D / 32)};
            else if (q == 12) t = TJob{in[13], (bf16*)(ws + WS_DSA_IN_T), D, DSA_IN_SRC, DSA_INP, 0, (D / 64) * (DSA_INP / 32)};
            else if (q == 13) t = TJob{in[16], (bf16*)(ws + WS_DSA_UQ_T), 512, 2048, 2048, 0, (512 / 64) * (2048 / 32)};
            else if (q == 14) t = TJob{in[18], (bf16*)(ws + WS_DSA_UQ_T), 512, 1024, 1024, 2048, (512 / 64) * (1024 / 32)};
            else if (q == 15) t = TJob{in[17], (bf16*)(ws + WS_DSA_UKV_T), 256, 256, 256, 0, (256 / 64) * (256 / 32)};
            else if (q == 16) t = TJob{in[21], (bf16*)(ws + WS_DSA_OUT_T), D, D, D, 0, (D / 64) * (D / 32)};
            else if (q == 17) t = TJob{in[22], (bf16*)(ws + WS_DIL_IN_T), D, DIL_IN, DIL_IN, 0, (D / 64) * (DIL_IN / 32)};
            else              t = TJob{in[25], (bf16*)(ws + WS_DIL_OUT_T), 1024, D, D, 0, (1024 / 64) * (D / 32)};
            if (!found) { if (r < t.items) { jb = t; found = true; } else r -= t.items; }
        }
        if (!found) break;
        p0_transpose_item(jb.src, jb.K, jb.Nsrc, jb.Npad, jb.dst, jb.row_off, scr, r, F.lane);
    }
}

__device__ __forceinline__ void norm_phase(const Frame& F0, const float* x, const float* gain, const float* modl, int sh_off, int sc_off, bf16* H) {
    Frame F = F0; F.lane = opq(lane_id()); F.tid = F0.wave * 64 + F.lane;
    for (int rg = F.gw; rg < M / 8; rg += F.NGW) {
        const int m0 = rg * 8, b = m0 / S;
        const float* mb = modl + (size_t)b * 12288;
        f32x4 A[8], Sh[8];
#pragma unroll
        for (int j = 0; j < 8; ++j) { const int col = 4 * (F.lane + 64 * j); const f32x4 g = *(const f32x4*)(gain + col), sc = *(const f32x4*)(mb + sc_off + col); Sh[j] = *(const f32x4*)(mb + sh_off + col); A[j] = g * (sc + 1.0f); }
        for (int r = 0; r < 8; ++r) {
            const GAS f32x4* xr = (const GAS f32x4*)(x + (size_t)(m0 + r) * D) + F.lane;
            f32x4 v[8]; float ss = 0.f;
#pragma unroll
            for (int j = 0; j < 8; ++j) { v[j] = xr[64 * j]; ss += (v[j].x * v[j].x + v[j].y * v[j].y) + (v[j].z * v[j].z + v[j].w * v[j].w); }
            const float rstd = 1.0f / sqrtf(wave_sum(ss) * (1.f / D) + EPS);
            GAS v2u* o8 = (GAS v2u*)(H + (size_t)(m0 + r) * D) + F.lane;
#pragma unroll
            for (int j = 0; j < 8; ++j) { const f32x4 h = v[j] * rstd * A[j] + Sh[j]; v2u w; w.x = pk2(h.x, h.y); w.y = pk2(h.z, h.w); o8[64 * j] = w; }
        }
    }
}

template <int KIND>
__device__ __forceinline__ void qknorm_phase(const Frame& F0, bf16* P, int pitch, const float* qn, const float* kn, bf16* KT) {
    Frame F = F0; F.lane = opq(lane_id()); F.tid = F0.wave * 64 + F.lane;
    constexpr int NCOLS = KIND == 0 ? 2048 : DIL_IN;
    for (int m = F.gw; m < M; m += F.NGW) {
        bf16* row = P + (size_t)m * pitch;
        for (int c0 = 0; c0 < NCOLS; c0 += 512) {
            const int col = c0 + 8 * F.lane;
            bool act; const float* g;
            if (KIND == 0) { act = true; g = qn + (col & 63); }
            else { const int gi = col / 1536, cl = col - gi * 1536; act = cl < 1024; g = qn + gi * 64 + (col & 63); }
            float f[8]; float ss = 0.f;
            if (act) { const v4u w = *(const GAS v4u*)(row + col); unpack8(w, f);
#pragma unroll
                for (int e = 0; e < 8; ++e) ss += f[e] * f[e]; }
            ss += __shfl_xor(ss, 1); ss += __shfl_xor(ss, 2); ss += __shfl_xor(ss, 4);
            if (act) { const float rstd = 1.0f / sqrtf(ss * (1.f / 64.f) + EPS); const f32x4 g0 = *(const f32x4*)g, g1 = *(const f32x4*)(g + 4);
                v4u o; o.x = pk2(f[0] * rstd * g0.x, f[1] * rstd * g0.y); o.y = pk2(f[2] * rstd * g0.z, f[3] * rstd * g0.w); o.z = pk2(f[4] * rstd * g1.x, f[5] * rstd * g1.y); o.w = pk2(f[6] * rstd * g1.z, f[7] * rstd * g1.w);
                *(GAS v4u*)(row + col) = o; }
        }
    }
    constexpr int NG = KIND == 0 ? 1 : 3;
    for (int it = F.gw; it < NG * 2048; it += F.NGW) {
        const int gi = it >> 11, rem = it & 2047, b = rem >> 8, kvh = (rem >> 6) & 3, rt = rem & 63;
        const int dsh = 2 * gi, Ssub = S >> dsh, tpr = Ssub >> 5, r = rt / tpr, T = rt - r * tpr;
        const int pp = F.lane >> 1, half = F.lane & 1, u = 32 * T + kperm5(pp), t = (u << dsh) + r;
        const int kcol = (KIND == 0 ? 2048 : gi * 1536 + 1024) + kvh * 64 + half * 32;
        const bf16* src = P + ((size_t)b * S + t) * pitch + kcol;
        float f[32]; float ss = 0.f;
#pragma unroll
        for (int c = 0; c < 4; ++c) { const v4u w = *(const GAS v4u*)(src + 8 * c); unpack8(w, f + 8 * c); }
#pragma unroll
        for (int e = 0; e < 32; ++e) ss += f[e] * f[e];
        ss += __shfl_xor(ss, 1);
        const float rstd = 1.0f / sqrtf(ss * (1.f / 64.f) + EPS);
        const float* g = kn + gi * 64 + half * 32;
        bf16* dst = KT + ((size_t)((gi * 8 + b) * 4 + kvh)) * (64 * S) + (size_t)r * (Ssub * 64) + (size_t)T * 2048;
#pragma unroll
        for (int c = 0; c < 4; ++c) { const f32x4 g0 = *(const f32x4*)(g + 8 * c), g1 = *(const f32x4*)(g + 8 * c + 4); const float* x = f + 8 * c;
            v4u o; o.x = pk2(x[0] * rstd * g0.x, x[1] * rstd * g0.y); o.y = pk2(x[2] * rstd * g0.z, x[3] * rstd * g0.w); o.z = pk2(x[4] * rstd * g1.x, x[5] * rstd * g1.y); o.w = pk2(x[6] * rstd * g1.z, x[7] * rstd * g1.w);
            *(GAS v4u*)(dst + (((half * 2 + (c >> 1)) * 2 + (c & 1)) * 32 + pp) * 8) = o; }
    }
}

template <int G, int NSEG, bool SINK>
__device__ __forceinline__ void band_attn_naive(const Frame& F0, const bf16* P, int pitch, int segstride, int kbase, int vbase, bf16* O, int opitch, const float* sinks, int nslope) {
    Frame F = F0; F.lane = opq(lane_id()); F.tid = F0.wave * 64 + F.lane;
    constexpr int NSLOT = SINK ? 2 : 3, NKEYS = SINK ? 128 : 129;
    LAS float* qs = (LAS float*)(F.lds + RING_OFF + F.wave * 16384);
    LAS float* ps = qs + NSEG * G * 64;
    for (int item = F.gw; item < M * 4; item += F.NGW) {
        const int m = item >> 2, kvh = item & 3, t = m & (S - 1);
        asm volatile("" ::: "memory");
#pragma unroll
        for (int sg = 0; sg < NSEG; ++sg)
#pragma unroll
            for (int g = 0; g < G; ++g) qs[(sg * G + g) * 64 + F.lane] = bf2f(P[(size_t)m * pitch + sg * segstride + (kvh * G + g) * 64 + F.lane]);
        LDS_WAIT(); asm volatile("" ::: "memory");
        float lg[NSEG][NSLOT][G];
#pragma unroll
        for (int sg = 0; sg < NSEG; ++sg) {
            const int dil = sg == 0 ? 1 : (sg == 1 ? 4 : 16);
#pragma unroll
            for (int sl = 0; sl < NSLOT; ++sl) {
                asm volatile("" ::: "memory");
                const int j = sl * 64 + F.lane; const bool valid = (j < NKEYS) && (t - j * dil >= 0);
                const bf16* kr = P + (size_t)(m - (valid ? j * dil : 0)) * pitch + sg * segstride + kbase + kvh * 64;
                float kf[64];
#pragma unroll
                for (int i = 0; i < 8; ++i) { const v4u w = *(const GAS v4u*)(kr + 8 * i); unpack8(w, kf + 8 * i); }
#pragma unroll
                for (int g = 0; g < G; ++g) { float dot = 0.f;
#pragma unroll
                    for (int d4 = 0; d4 < 16; ++d4) { const f32x4 q4 = *(const LAS f32x4*)(qs + (sg * G + g) * 64 + 4 * d4); dot += kf[4 * d4] * q4.x + kf[4 * d4 + 1] * q4.y + kf[4 * d4 + 2] * q4.z + kf[4 * d4 + 3] * q4.w; }
                    const float slope = exp2f(-8.f * (float)(kvh * G + g + 1) / (float)nslope);
                    lg[sg][sl][g] = valid ? dot * 0.125f - slope * (float)(j * dil) : -INFINITY; }
            }
        }
#pragma unroll
        for (int g = 0; g < G; ++g) {
            float mx = -INFINITY;
#pragma unroll
            for (int sg = 0; sg < NSEG; ++sg)
#pragma unroll
                for (int sl = 0; sl < NSLOT; ++sl) mx = fmaxf(mx, lg[sg][sl][g]);
            mx = wave_max(mx);
            float sk = 0.f; if (SINK) { sk = sinks[kvh * G + g]; mx = fmaxf(mx, sk); }
            float sum = 0.f;
#pragma unroll
            for (int sg = 0; sg < NSEG; ++sg)
#pragma unroll
                for (int sl = 0; sl < NSLOT; ++sl) { const float e = __expf(lg[sg][sl][g] - mx); lg[sg][sl][g] = e; sum += e; }
            sum = wave_sum(sum); if (SINK) sum += __expf(sk - mx);
            const float inv = 1.0f / sum;
#pragma unroll
            for (int sg = 0; sg < NSEG; ++sg)
#pragma unroll
                for (int sl = 0; sl < NSLOT; ++sl) ps[(sg * 192 + sl * 64 + F.lane) * G + g] = lg[sg][sl][g] * inv;
        }
        LDS_WAIT(); asm volatile("" ::: "memory");
        float o[G];
#pragma unroll
        for (int g = 0; g < G; ++g) o[g] = 0.f;
#pragma unroll
        for (int sg = 0; sg < NSEG; ++sg) {
            const int dil = sg == 0 ? 1 : (sg == 1 ? 4 : 16);
            const int jmax = min(NKEYS - 1, t / dil);
            const bf16* vb = P + (size_t)m * pitch + sg * segstride + vbase + kvh * 64 + F.lane;
            for (int j0 = 0; j0 <= jmax; j0 += 8) {
                float v[8];
#pragma unroll
                for (int u = 0; u < 8; ++u) { const int jj = min(j0 + u, jmax); v[u] = bf2f(vb[-(ptrdiff_t)jj * dil * pitch]); }
#pragma unroll
                for (int u = 0; u < 8; ++u)
#pragma unroll
                    for (int g4 = 0; g4 < G; g4 += 4) { const f32x4 p4 = *(const LAS f32x4*)(ps + (sg * 192 + j0 + u) * G + g4); o[g4] += p4.x * v[u]; o[g4 + 1] += p4.y * v[u]; o[g4 + 2] += p4.z * v[u]; o[g4 + 3] += p4.w * v[u]; }
            }
        }
#pragma unroll
        for (int g = 0; g < G; ++g) O[(size_t)m * opitch + (kvh * G + g) * 64 + F.lane] = (bf16)f2bf(o[g]);
    }
}

__device__ __forceinline__ void dsa_latnorm_phase(const Frame& F0, const bf16* LAT, bf16* QL, bf16* KVL, const float* qg, const float* kvg, bf16* KI) {
    Frame F = F0; F.lane = opq(lane_id()); F.tid = F0.wave * 64 + F.lane;
    for (int m = F.gw; m < M; m += F.NGW) {
        const bf16* row = LAT + (size_t)m * DSA_INP;
        float f[8]; { const v4u w = *(const GAS v4u*)(row + 8 * F.lane); unpack8(w, f); }
        float ss = 0.f;
#pragma unroll
        for (int e = 0; e < 8; ++e) ss += f[e] * f[e];
        const float rq = 1.0f / sqrtf(wave_sum(ss) * (1.f / 512.f) + EPS);
        { const f32x4 g0 = *(const f32x4*)(qg + 8 * F.lane), g1 = *(const f32x4*)(qg + 8 * F.lane + 4);
          v4u o; o.x = pk2(f[0] * rq * g0.x, f[1] * rq * g0.y); o.y = pk2(f[2] * rq * g0.z, f[3] * rq * g0.w); o.z = pk2(f[4] * rq * g1.x, f[5] * rq * g1.y); o.w = pk2(f[6] * rq * g1.z, f[7] * rq * g1.w);
          *(GAS v4u*)(QL + (size_t)m * 512 + 8 * F.lane) = o; }
        float h[8]; float s2 = 0.f; const bool act = F.lane < 32;
        if (act) { const v4u w = *(const GAS v4u*)(row + 512 + 8 * F.lane); unpack8(w, h);
#pragma unroll
            for (int e = 0; e < 8; ++e) s2 += h[e] * h[e]; }
        s2 += __shfl_xor(s2, 1); s2 += __shfl_xor(s2, 2); s2 += __shfl_xor(s2, 4); s2 += __shfl_xor(s2, 8); s2 += __shfl_xor(s2, 16);
        if (act) { const float rk = 1.0f / sqrtf(s2 * (1.f / 256.f) + EPS); const f32x4 g0 = *(const f32x4*)(kvg + 8 * F.lane), g1 = *(const f32x4*)(kvg + 8 * F.lane + 4);
          v4u o; o.x = pk2(h[0] * rk * g0.x, h[1] * rk * g0.y); o.y = pk2(h[2] * rk * g0.z, h[3] * rk * g0.w); o.z = pk2(h[4] * rk * g1.x, h[5] * rk * g1.y); o.w = pk2(h[6] * rk * g1.z, h[7] * rk * g1.w);
          *(GAS v4u*)(KVL + (size_t)m * 256 + 8 * F.lane) = o; }
        if (F.lane < 8) { const int t = m & (S - 1), bq = m / S, d0 = 8 * F.lane; const v4u w = *(const GAS v4u*)(row + 768 + d0);
          *(GAS v4u*)(KI + ((size_t)(bq * 64 + (t >> 5)) * 4 + (d0 >> 4)) * 512 + (((d0 >> 3) & 1) * 32 + (t & 31)) * 8) = w; }
    }
}

__device__ __forceinline__ void dsa_qknorm(const Frame& F0, bf16* QQ, bf16* KV, const float* qn, const float* kn, bf16* KTd) {
    Frame F = F0; F.lane = opq(lane_id()); F.tid = F0.wave * 64 + F.lane;
    for (int m = F.gw; m < M; m += F.NGW) {
#pragma unroll
        for (int c = 0; c < 5; ++c) {
            const bool act = c < 4 || F.lane < 16;
            bf16* p = c < 4 ? QQ + (size_t)m * DSA_QQ + 512 * c + 8 * F.lane : KV + (size_t)m * 256 + 8 * F.lane;
            const float* g = (c < 4 ? qn : kn) + ((8 * F.lane) & 127);
            float f[8]; float ss = 0.f;
            if (act) { const v4u w = *(const GAS v4u*)p; unpack8(w, f);
#pragma unroll
                for (int e = 0; e < 8; ++e) ss += f[e] * f[e]; }
            ss += __shfl_xor(ss, 1); ss += __shfl_xor(ss, 2); ss += __shfl_xor(ss, 4); ss += __shfl_xor(ss, 8);
            if (act) { const float r = 1.0f / sqrtf(ss * (1.f / 128.f) + EPS); const f32x4 g0 = *(const f32x4*)g, g1 = *(const f32x4*)(g + 4);
                v4u o; o.x = pk2(f[0] * r * g0.x, f[1] * r * g0.y); o.y = pk2(f[2] * r * g0.z, f[3] * r * g0.w); o.z = pk2(f[4] * r * g1.x, f[5] * r * g1.y); o.w = pk2(f[6] * r * g1.z, f[7] * r * g1.w);
                *(GAS v4u*)p = o;
                if (c == 4) { const int t = m & (S - 1), bq = m / S, d0 = 8 * F.lane;
                    *(GAS v4u*)(KTd + ((size_t)(bq * 64 + (t >> 5)) * 8 + (d0 >> 4)) * 512 + (((d0 >> 3) & 1) * 32 + kperm5(t & 31)) * 8) = o; } }
        }
    }
}

__device__ __forceinline__ unsigned f2key(float x) { const unsigned u = __float_as_uint(x); return (u & 0x80000000u) ? ~u : (u | 0x80000000u); }
__device__ __forceinline__ void dsa_index_naive(const Frame& F0, const bf16* LAT, const bf16* QQ, unsigned short* IDX, int* NSEL) {
    Frame F = F0; F.lane = opq(lane_id()); F.tid = F0.wave * 64 + F.lane;
    LAS float* qi = (LAS float*)(F.lds + RING_OFF + F.wave * 16384);
    LAS unsigned* skey = (LAS unsigned*)(qi + 1024);
    LAS float* wl = (LAS float*)(skey + 2048);
    const unsigned long long ltmask = (1ull << F.lane) - 1ull;
    for (int m = F.gw; m < M; m += F.NGW) {
        const int t = m & (S - 1), b0 = m - t;
        if (t < 256) {
            for (int jj = F.lane; jj < 256; jj += 64) if (jj <= t) IDX[(size_t)m * 256 + jj] = (unsigned short)jj;
            if (F.lane == 0) NSEL[m] = t + 1;
            continue;
        }
        asm volatile("" ::: "memory");
#pragma unroll
        for (int r = 0; r < 2; ++r) { const int e = (r * 64 + F.lane) * 8; const v4u w = *(const GAS v4u*)(QQ + (size_t)m * DSA_QQ + 2048 + e); float f[8]; unpack8(w, f);
#pragma unroll
            for (int i = 0; i < 8; ++i) qi[e + i] = f[i]; }
        if (F.lane < 16) wl[F.lane] = bf2f(LAT[(size_t)m * DSA_INP + 832 + F.lane]) * (0.25f * 0.125f);
        LDS_WAIT(); asm volatile("" ::: "memory");
        const int nch = (t >> 6) + 1;
#pragma unroll 1
        for (int c = 0; c < nch; ++c) {
            asm volatile("" ::: "memory");
            const int s = c * 64 + F.lane; const bool valid = s <= t;
            const bf16* kr = LAT + (size_t)(b0 + (valid ? s : t)) * DSA_INP + 768;
            v4u kw[8];
#pragma unroll
            for (int i = 0; i < 8; ++i) kw[i] = *(const GAS v4u*)(kr + 8 * i);
            float kf[64];
#pragma unroll
            for (int i = 0; i < 8; ++i) unpack8(kw[i], kf + 8 * i);
            float sc = 0.f;
#pragma unroll 1
            for (int h = 0; h < 16; ++h) {
                float dot = 0.f;
#pragma unroll
                for (int d4 = 0; d4 < 16; ++d4) { const f32x4 q4 = *(const LAS f32x4*)(qi + h * 64 + 4 * d4); dot += (kf[4 * d4] * q4.x + kf[4 * d4 + 1] * q4.y) + (kf[4 * d4 + 2] * q4.z + kf[4 * d4 + 3] * q4.w); }
                sc += wl[h] * fmaxf(dot, 0.f);
            }
            skey[s] = valid ? f2key(sc) : 0u;
        }
        LDS_WAIT(); asm volatile("" ::: "memory");
        unsigned key[32];
#pragma unroll
        for (int c = 0; c < 32; ++c) key[c] = (c < nch) ? skey[c * 64 + F.lane] : 0u;
        unsigned T = 0u;
        for (int bit = 31; bit >= 0; --bit) {
            const unsigned cand = T | (1u << bit); int cnt = 0;
#pragma unroll
            for (int c = 0; c < 32; ++c) cnt += __popcll(__ballot(key[c] >= cand));
            if (cnt >= 256) T = cand;
        }
        int cgt = 0;
#pragma unroll
        for (int c = 0; c < 32; ++c) cgt += __popcll(__ballot(key[c] > T));
        const int need_eq = 256 - cgt;
        int base = 0, eqbase = 0;
#pragma unroll
        for (int c = 0; c < 32; ++c) {
            const bool gt = key[c] > T, eq = key[c] == T;
            const unsigned long long meq = __ballot(eq);
            const int eqrank = eqbase + __popcll(meq & ltmask);
            const bool sel = gt || (eq && eqrank < need_eq);
            const unsigned long long msel = __ballot(sel);
            const int pos = base + __popcll(msel & ltmask);
            if (sel && pos < 256) IDX[(size_t)m * 256 + pos] = (unsigned short)(c * 64 + F.lane);
            base += __popcll(msel); eqbase += __popcll(meq);
        }
        if (F.lane == 0) NSEL[m] = base < 256 ? base : 256;
    }
}

__device__ __forceinline__ void dsa_attn_naive(const Frame& F0, const bf16* QQ, const bf16* KV, const unsigned short* IDX, const int* NSEL, bf16* O) {
    Frame F = F0; F.lane = opq(lane_id()); F.tid = F0.wave * 64 + F.lane;
    LAS float* qs = (LAS float*)(F.lds + RING_OFF + F.wave * 16384);
    LAS float* ps = qs + 2048;
    for (int m = F.gw; m < M; m += F.NGW) {
        const int t = m & (S - 1), b0 = m - t; const int n = NSEL[m];
        asm volatile("" ::: "memory");
#pragma unroll
        for (int r = 0; r < 4; ++r) { const int e = (r * 64 + F.lane) * 8; const v4u w = *(const GAS v4u*)(QQ + (size_t)m * DSA_QQ + e); float f[8]; unpack8(w, f);
            *(LAS f32x4*)(qs + e) = (f32x4){f[0], f[1], f[2], f[3]}; *(LAS f32x4*)(qs + e + 4) = (f32x4){f[4], f[5], f[6], f[7]}; }
        LDS_WAIT(); asm volatile("" ::: "memory");
        int sidx[4];
#pragma unroll
        for (int sl = 0; sl < 4; ++sl) { const int jj = sl * 64 + F.lane; sidx[sl] = (jj < n) ? (int)IDX[(size_t)m * 256 + jj] : 0; }
#pragma unroll 1
        for (int hh = 0; hh < 2; ++hh) {
#pragma unroll 1
            for (int sl = 0; sl < 4; ++sl) {
                const int jj = sl * 64 + F.lane; const bool val = jj < n; const int sx = val ? (int)IDX[(size_t)m * 256 + jj] : 0;
                const bf16* kr = KV + (size_t)(b0 + sx) * 256;
                float kf[128];
#pragma unroll
                for (int i = 0; i < 16; ++i) { const v4u w = *(const GAS v4u*)(kr + 8 * i); unpack8(w, kf + 8 * i); }
#pragma unroll 1
                for (int h = 0; h < 8; ++h) {
                    const LAS float* qh = qs + (hh * 8 + h) * 128; float dot = 0.f;
#pragma unroll
                    for (int d4 = 0; d4 < 32; ++d4) { const f32x4 q4 = *(const LAS f32x4*)(qh + 4 * d4); dot += (kf[4 * d4] * q4.x + kf[4 * d4 + 1] * q4.y) + (kf[4 * d4 + 2] * q4.z + kf[4 * d4 + 3] * q4.w); }
                    const float slope = exp2f(-0.5f * (float)(hh * 8 + h + 1));
                    ps[jj * 8 + h] = val ? dot * 0.08838834764831845f - slope * (float)(t - sx) : -INFINITY;
                }
            }
            LDS_WAIT(); asm volatile("" ::: "memory");
            float inv_sum[8];
#pragma unroll
            for (int h = 0; h < 8; ++h) {
                float l0 = ps[(F.lane) * 8 + h], l1 = ps[(64 + F.lane) * 8 + h], l2 = ps[(128 + F.lane) * 8 + h], l3 = ps[(192 + F.lane) * 8 + h];
                const float mx = wave_max(fmaxf(fmaxf(l0, l1), fmaxf(l2, l3)));
                l0 = __expf(l0 - mx); l1 = __expf(l1 - mx); l2 = __expf(l2 - mx); l3 = __expf(l3 - mx);
                inv_sum[h] = 1.0f / wave_sum((l0 + l1) + (l2 + l3));
                ps[(F.lane) * 8 + h] = l0; ps[(64 + F.lane) * 8 + h] = l1; ps[(128 + F.lane) * 8 + h] = l2; ps[(192 + F.lane) * 8 + h] = l3;
            }
            LDS_WAIT(); asm volatile("" ::: "memory");
            float o[8][2];
#pragma unroll
            for (int h = 0; h < 8; ++h) { o[h][0] = 0.f; o[h][1] = 0.f; }
#pragma unroll
            for (int sl = 0; sl < 4; ++sl) {
                if (sl * 64 < n) {
#pragma unroll 1
                    for (int j0 = 0; j0 < 64; j0 += 4) {
                        unsigned vw[4];
#pragma unroll
                        for (int u = 0; u < 4; ++u) { const int sx = __builtin_amdgcn_readlane(sidx[sl], j0 + u); vw[u] = *(const GAS unsigned*)(KV + (size_t)(b0 + sx) * 256 + 128 + 2 * F.lane); }
#pragma unroll
                        for (int u = 0; u < 4; ++u) {
                            const float v0 = bflo(vw[u]), v1 = bfhi(vw[u]); const int jj = sl * 64 + j0 + u;
                            const f32x4 p0 = *(const LAS f32x4*)(ps + jj * 8), p1 = *(const LAS f32x4*)(ps + jj * 8 + 4);
                            o[0][0] += p0.x * v0; o[0][1] += p0.x * v1; o[1][0] += p0.y * v0; o[1][1] += p0.y * v1; o[2][0] += p0.z * v0; o[2][1] += p0.z * v1; o[3][0] += p0.w * v0; o[3][1] += p0.w * v1;
                            o[4][0] += p1.x * v0; o[4][1] += p1.x * v1; o[5][0] += p1.y * v0; o[5][1] += p1.y * v1; o[6][0] += p1.z * v0; o[6][1] += p1.z * v1; o[7][0] += p1.w * v0; o[7][1] += p1.w * v1;
                        }
                    }
                }
            }
#pragma unroll
            for (int h = 0; h < 8; ++h) *(GAS unsigned*)(O + (size_t)m * D + (hh * 8 + h) * 128 + 2 * F.lane) = pk2(o[h][0] * inv_sum[h], o[h][1] * inv_sum[h]);
            LDS_WAIT(); asm volatile("" ::: "memory");
        }
    }
}
typedef short bf16x8v __attribute__((ext_vector_type(8)));
typedef float f32x16v __attribute__((ext_vector_type(16)));
__device__ __forceinline__ bf16x8v ld_frag(const bf16* p) { return __builtin_bit_cast(bf16x8v, *(const GAS v4u*)p); }
__device__ __forceinline__ bf16x8v pack_frag(float a0, float a1, float a2, float a3, float a4, float a5, float a6, float a7) {
    v4u w; w.x = pg8::cvt_pk_bf16(a0, a1); w.y = pg8::cvt_pk_bf16(a2, a3); w.z = pg8::cvt_pk_bf16(a4, a5); w.w = pg8::cvt_pk_bf16(a6, a7); return __builtin_bit_cast(bf16x8v, w); }
template <int G, bool SINK>
__device__ __forceinline__ void band_attn_mfma(const Frame& F0, const bf16* P, int pitch, int qcol0, const bf16* KT, const bf16* VT, int dshift, bf16* Ob, int opitch, int ocol0, float* LSE, const float* sinks, int nheads_total) {
    Frame F = F0; F.lane = opq(lane_id()); F.tid = F0.wave * 64 + F.lane;
    constexpr int QPI = 32 / G, WMAX = SINK ? 127 : 128;
    const int Ssub = S >> dshift, per = Ssub / QPI, nitems = BATCH * 4 * (S / QPI);
    const int l31 = F.lane & 31, hh = F.lane >> 5;
    const int kperm = (l31 & ~12) | ((l31 & 4) << 1) | ((l31 & 8) >> 1);
    const int qi = l31 / G, hd = l31 % G;
    for (int item = F.gw; item < nitems; item += F.NGW) {
        const int qg = item % per, rest = item / per, r = rest & ((1 << dshift) - 1), rest2 = rest >> dshift, kvh = rest2 & 3, b = rest2 >> 2;
        const int u0 = qg * QPI, kt0 = (u0 >> 5) - 4, kstart = 32 * kt0;
        const size_t tbase = ((size_t)(b * 4 + kvh)) * (64 * S) + (size_t)r * (Ssub * 64);
        const int u = u0 + qi, head = kvh * G + hd;
        const size_t m = (size_t)b * S + ((size_t)u << dshift) + r;
        const float slope = exp2f(-8.f * (float)(head + 1) / (float)nheads_total) * (float)(1 << dshift);
        bf16x8v qf[4];
#pragma unroll
        for (int ks = 0; ks < 4; ++ks) qf[ks] = ld_frag(P + m * pitch + qcol0 + head * 64 + 16 * ks + 8 * hh);
        bf16x8v kf[5][4];
#pragma unroll
        for (int T = 0; T < 5; ++T) {
            const int kt = (kt0 + T) < 0 ? 0 : (kt0 + T);
            const bf16* kr = KT + tbase + (size_t)kt * 2048;
#pragma unroll
            for (int ks = 0; ks < 4; ++ks) kf[T][ks] = ld_frag(kr + ks * 512 + F.lane * 8);
        }
        f32x16v sT[5];
#pragma unroll
        for (int T = 0; T < 5; ++T) {
            const int tb = kstart + 32 * T;
            f32x16v acc;
#pragma unroll
            for (int e = 0; e < 16; ++e) acc[e] = 0.f;
#pragma unroll
            for (int ks = 0; ks < 4; ++ks) acc = __builtin_amdgcn_mfma_f32_32x32x16_bf16(kf[T][ks], qf[ks], acc, 0, 0, 0);
#pragma unroll
            for (int e = 0; e < 16; ++e) { const int ko = 16 * (e >> 3) + 8 * hh + 4 * ((e >> 2) & 1) + (e & 3); const int s = tb + ko, dist = u - s;
                const bool valid = (dist >= 0) && (dist <= WMAX) && (s >= 0);
                acc[e] = valid ? acc[e] * 0.125f - slope * (float)dist : -INFINITY; }
            sT[T] = acc;
        }
        bf16x8v vf[5][2][2];
#pragma unroll
        for (int T = 0; T < 5; ++T) {
            const int kt = (kt0 + T) < 0 ? 0 : (kt0 + T);
            const bf16* vr = VT + tbase + (size_t)kt * 2048;
#pragma unroll
            for (int s2 = 0; s2 < 2; ++s2)
#pragma unroll
                for (int c = 0; c < 2; ++c) vf[T][s2][c] = ld_frag(vr + c * 1024 + 16 * s2 + l31 * 32 + 8 * hh);
        }
        float mx = -INFINITY;
#pragma unroll
        for (int T = 0; T < 5; ++T)
#pragma unroll
            for (int e = 0; e < 16; ++e) mx = fmaxf(mx, sT[T][e]);
        mx = fmaxf(mx, __shfl_xor(mx, 32));
        float sk = 0.f; if (SINK) { sk = sinks[head]; mx = fmaxf(mx, sk); }
        float sum = 0.f;
#pragma unroll
        for (int T = 0; T < 5; ++T)
#pragma unroll
            for (int e = 0; e < 16; ++e) { const float p = __expf(sT[T][e] - mx); sT[T][e] = p; sum += p; }
        sum += __shfl_xor(sum, 32);
        if (SINK) sum += __expf(sk - mx);
        f32x16v oT[2];
#pragma unroll
        for (int c = 0; c < 2; ++c)
#pragma unroll
            for (int e = 0; e < 16; ++e) oT[c][e] = 0.f;
#pragma unroll
        for (int T = 0; T < 5; ++T)
#pragma unroll
            for (int s2 = 0; s2 < 2; ++s2) {
                const bf16x8v pb = pack_frag(sT[T][8 * s2], sT[T][8 * s2 + 1], sT[T][8 * s2 + 2], sT[T][8 * s2 + 3], sT[T][8 * s2 + 4], sT[T][8 * s2 + 5], sT[T][8 * s2 + 6], sT[T][8 * s2 + 7]);
#pragma unroll
                for (int c = 0; c < 2; ++c) oT[c] = __builtin_amdgcn_mfma_f32_32x32x16_bf16(vf[T][s2][c], pb, oT[c], 0, 0, 0);
            }
        const float inv = 1.0f / sum;
        bf16* orow = Ob + m * opitch + ocol0 + head * 64 + 4 * hh;
#pragma unroll
        for (int c = 0; c < 2; ++c)
#pragma unroll
            for (int r4 = 0; r4 < 4; ++r4) { v2u w; w.x = pg8::cvt_pk_bf16(oT[c][4 * r4] * inv, oT[c][4 * r4 + 1] * inv); w.y = pg8::cvt_pk_bf16(oT[c][4 * r4 + 2] * inv, oT[c][4 * r4 + 3] * inv);
                *(GAS v2u*)(orow + 32 * c + 8 * r4) = w; }
        if (!SINK) { if (hh == 0) LSE[m * 16 + head] = mx + __logf(sum); }
    }
}
__device__ __forceinline__ void dil_combine(const Frame& F0, const bf16* P, const float* LSE, bf16* O) {
    Frame F = F0; F.lane = opq(lane_id()); F.tid = F0.wave * 64 + F.lane;
    for (int m = F.gw; m < M; m += F.NGW) {
#pragma unroll
        for (int i = 0; i < 2; ++i) {
            const int col = 8 * F.lane + 512 * i, head = col >> 6;
            const float l0 = LSE[(size_t)m * 16 + head], l1 = LSE[(size_t)(M + m) * 16 + head], l2 = LSE[(size_t)(2 * M + m) * 16 + head];
            const float mx = fmaxf(l0, fmaxf(l1, l2)); float w0 = __expf(l0 - mx), w1 = __expf(l1 - mx), w2 = __expf(l2 - mx); const float inv = 1.0f / (w0 + w1 + w2); w0 *= inv; w1 *= inv; w2 *= inv;
            float a[8], bq[8], c[8];
            unpack8(*(const GAS v4u*)(P + (size_t)m * DIL_IN + col), a); unpack8(*(const GAS v4u*)(P + (size_t)m * DIL_IN + 1536 + col), bq); unpack8(*(const GAS v4u*)(P + (size_t)m * DIL_IN + 3072 + col), c);
            v4u o; o.x = pk2(w0 * a[0] + w1 * bq[0] + w2 * c[0], w0 * a[1] + w1 * bq[1] + w2 * c[1]); o.y = pk2(w0 * a[2] + w1 * bq[2] + w2 * c[2], w0 * a[3] + w1 * bq[3] + w2 * c[3]);
            o.z = pk2(w0 * a[4] + w1 * bq[4] + w2 * c[4], w0 * a[5] + w1 * bq[5] + w2 * c[5]); o.w = pk2(w0 * a[6] + w1 * bq[6] + w2 * c[6], w0 * a[7] + w1 * bq[7] + w2 * c[7]);
            *(GAS v4u*)(O + (size_t)m * 1024 + col) = o;
        }
    }
}
template <int KIND>
__device__ __forceinline__ void qknorm_old(const Frame& F0, bf16* P, int pitch, const float* qn, const float* kn) {
    Frame F = F0; F.lane = opq(lane_id()); F.tid = F0.wave * 64 + F.lane;
    constexpr int NCOLS = KIND == 0 ? 2304 : DIL_IN;
    for (int m = F.gw; m < M; m += F.NGW) {
        bf16* row = P + (size_t)m * pitch;
        for (int c0 = 0; c0 < NCOLS; c0 += 512) {
            const int col = c0 + 8 * F.lane;
            bool act; const float* g;
            if (KIND == 0) { act = col < 2304; g = (col < 2048 ? qn : kn) + (col & 63); }
            else { const int gi = col / 1536, cl = col - gi * 1536; act = cl < 1280; g = (cl < 1024 ? qn : kn) + gi * 64 + (col & 63); }
            float f[8]; float ss = 0.f;
            if (act) { const v4u w = *(const GAS v4u*)(row + col); unpack8(w, f);
#pragma unroll
                for (int e = 0; e < 8; ++e) ss += f[e] * f[e]; }
            ss += __shfl_xor(ss, 1); ss += __shfl_xor(ss, 2); ss += __shfl_xor(ss, 4);
            if (act) { const float rstd = 1.0f / sqrtf(ss * (1.f / 64.f) + EPS); const f32x4 g0 = *(const f32x4*)g, g1 = *(const f32x4*)(g + 4);
                v4u o; o.x = pk2(f[0] * rstd * g0.x, f[1] * rstd * g0.y); o.y = pk2(f[2] * rstd * g0.z, f[3] * rstd * g0.w); o.z = pk2(f[4] * rstd * g1.x, f[5] * rstd * g1.y); o.w = pk2(f[6] * rstd * g1.z, f[7] * rstd * g1.w);
                *(GAS v4u*)(row + col) = o; }
        }
    }
}

template <int G, bool SINK>
__device__ __forceinline__ void band_attn_old(const Frame& F0, const bf16* P, int pitch, int qcol0, int kcol0, const bf16* VT, int dshift, bf16* Ob, int opitch, int ocol0, float* LSE, const float* sinks, int nheads_total) {
    Frame F = F0; F.lane = opq(lane_id()); F.tid = F0.wave * 64 + F.lane;
    constexpr int QPI = 32 / G, WMAX = SINK ? 127 : 128;
    const int Ssub = S >> dshift, per = Ssub / QPI, nitems = BATCH * 4 * (S / QPI);
    const int l31 = F.lane & 31, hh = F.lane >> 5;
    const int kperm = (l31 & ~12) | ((l31 & 4) << 1) | ((l31 & 8) >> 1);
    const int qi = l31 / G, hd = l31 % G;
    for (int item = F.gw; item < nitems; item += F.NGW) {
        const int qg = item % per, rest = item / per, r = rest & ((1 << dshift) - 1), rest2 = rest >> dshift, kvh = rest2 & 3, b = rest2 >> 2;
        const int u0 = qg * QPI, kstart = (u0 - 128) & ~7;
        const int u = u0 + qi, head = kvh * G + hd;
        const size_t m = (size_t)b * S + ((size_t)u << dshift) + r;
        const float slope = exp2f(-8.f * (float)(head + 1) / (float)nheads_total) * (float)(1 << dshift);
        bf16x8v qf[4];
#pragma unroll
        for (int ks = 0; ks < 4; ++ks) qf[ks] = ld_frag(P + m * pitch + qcol0 + head * 64 + 16 * ks + 8 * hh);
        f32x16v sT[5];
#pragma unroll
        for (int T = 0; T < 5; ++T) {
            const int tb = kstart + 32 * T;
            int sl = tb + kperm; sl = sl < 0 ? 0 : (sl > Ssub - 1 ? Ssub - 1 : sl);
            const bf16* kr = P + ((size_t)b * S + ((size_t)sl << dshift) + r) * pitch + kcol0 + kvh * 64 + 8 * hh;
            bf16x8v kf[4];
#pragma unroll
            for (int ks = 0; ks < 4; ++ks) kf[ks] = ld_frag(kr + 16 * ks);
            f32x16v acc;
#pragma unroll
            for (int e = 0; e < 16; ++e) acc[e] = 0.f;
#pragma unroll
            for (int ks = 0; ks < 4; ++ks) acc = __builtin_amdgcn_mfma_f32_32x32x16_bf16(kf[ks], qf[ks], acc, 0, 0, 0);
#pragma unroll
            for (int e = 0; e < 16; ++e) { const int ko = 16 * (e >> 3) + 8 * hh + 4 * ((e >> 2) & 1) + (e & 3); const int s = tb + ko, dist = u - s;
                const bool valid = (dist >= 0) && (dist <= WMAX) && (s >= 0);
                acc[e] = valid ? acc[e] * 0.125f - slope * (float)dist : -INFINITY; }
            sT[T] = acc;
        }
        float mx = -INFINITY;
#pragma unroll
        for (int T = 0; T < 5; ++T)
#pragma unroll
            for (int e = 0; e < 16; ++e) mx = fmaxf(mx, sT[T][e]);
        mx = fmaxf(mx, __shfl_xor(mx, 32));
        float sk = 0.f; if (SINK) { sk = sinks[head]; mx = fmaxf(mx, sk); }
        float sum = 0.f;
#pragma unroll
        for (int T = 0; T < 5; ++T)
#pragma unroll
            for (int e = 0; e < 16; ++e) { const float p = __expf(sT[T][e] - mx); sT[T][e] = p; sum += p; }
        sum += __shfl_xor(sum, 32);
        if (SINK) sum += __expf(sk - mx);
        f32x16v oT[2];
#pragma unroll
        for (int c = 0; c < 2; ++c)
#pragma unroll
            for (int e = 0; e < 16; ++e) oT[c][e] = 0.f;
        const bf16* vbase = VT + ((size_t)(b * 4 + kvh) * 64 + l31) * S + (size_t)r * Ssub;
#pragma unroll
        for (int T = 0; T < 5; ++T)
#pragma unroll
            for (int s2 = 0; s2 < 2; ++s2) {
                int kb = kstart + 32 * T + 16 * s2 + 8 * hh; kb = kb < 0 ? 0 : (kb > Ssub - 8 ? Ssub - 8 : kb);
                const bf16x8v pb = pack_frag(sT[T][8 * s2], sT[T][8 * s2 + 1], sT[T][8 * s2 + 2], sT[T][8 * s2 + 3], sT[T][8 * s2 + 4], sT[T][8 * s2 + 5], sT[T][8 * s2 + 6], sT[T][8 * s2 + 7]);
#pragma unroll
                for (int c = 0; c < 2; ++c) { const bf16x8v vf = ld_frag(vbase + (size_t)(32 * c) * S + kb); oT[c] = __builtin_amdgcn_mfma_f32_32x32x16_bf16(vf, pb, oT[c], 0, 0, 0); }
            }
        const float inv = 1.0f / sum;
        bf16* orow = Ob + m * opitch + ocol0 + head * 64 + 4 * hh;
#pragma unroll
        for (int c = 0; c < 2; ++c)
#pragma unroll
            for (int r4 = 0; r4 < 4; ++r4) { v2u w; w.x = pg8::cvt_pk_bf16(oT[c][4 * r4] * inv, oT[c][4 * r4 + 1] * inv); w.y = pg8::cvt_pk_bf16(oT[c][4 * r4 + 2] * inv, oT[c][4 * r4 + 3] * inv);
                *(GAS v2u*)(orow + 32 * c + 8 * r4) = w; }
        if (!SINK) { if (hh == 0) LSE[m * 16 + head] = mx + __logf(sum); }
    }
}
__device__ __forceinline__ void dsa_fused(const Frame& F0, const bf16* LAT, const bf16* QQ, const bf16* KTd, const bf16* KI, const bf16* VT, bf16* O, const bf16* KVraw) {
    Frame F = F0; F.lane = opq(lane_id()); F.tid = F0.wave * 64 + F.lane;
    LAS unsigned* sk = (LAS unsigned*)(F.lds + RING_OFF + F.wave * 16384);
    const int l31 = F.lane & 31, hh = F.lane >> 5;
    const int kperm = (l31 & ~12) | ((l31 & 4) << 1) | ((l31 & 8) >> 1);
    constexpr int NITEM = M / 2, PER_B = S / 2;
    int pass = 0;
    for (int item = F.gw; item < NITEM; item += F.NGW, ++pass) {
        const int b = item / PER_B; int tp = item % PER_B; if (pass & 1) tp = PER_B - 1 - tp;
        const int t0 = 2 * tp; const size_t b0 = (size_t)b * S, m0 = b0 + t0;
        const int ntile = ((t0 + 1) >> 5) + 1;
        asm volatile("" ::: "memory");
        {
            bf16x8v af[4];
            { const int qsel = (l31 >> 2) & 1, head = (l31 >> 3) * 4 + (l31 & 3);
#pragma unroll
              for (int ks = 0; ks < 4; ++ks) af[ks] = ld_frag(QQ + (m0 + qsel) * DSA_QQ + 2048 + head * 64 + 16 * ks + 8 * hh); }
            float wv[16];
            { float f[8]; unpack8(*(const GAS v4u*)(LAT + (m0 + hh) * DSA_INP + 832), f);
#pragma unroll
              for (int e = 0; e < 8; ++e) wv[e] = f[e] * (0.25f * 0.125f);
              unpack8(*(const GAS v4u*)(LAT + (m0 + hh) * DSA_INP + 840), f);
#pragma unroll
              for (int e = 0; e < 8; ++e) wv[8 + e] = f[e] * (0.25f * 0.125f); }
            const int tq = t0 + hh;
#define DSA_LDK(dst, T_) do { const bf16* kr_ = KI + ((size_t)b * 64 + (T_)) * 2048;   _Pragma("unroll") for (int ks = 0; ks < 4; ++ks) dst[ks] = ld_frag(kr_ + ks * 512 + F.lane * 8); } while (0)
#define DSA_SCORE(src, T_) do { f32x16v acc; _Pragma("unroll") for (int e = 0; e < 16; ++e) acc[e] = 0.f; \
                _Pragma("unroll") for (int ks = 0; ks < 4; ++ks) acc = __builtin_amdgcn_mfma_f32_32x32x16_bf16(af[ks], src[ks], acc, 0, 0, 0); \
                float sc = 0.f; _Pragma("unroll") for (int e = 0; e < 16; ++e) sc = __builtin_fmaf(wv[e], fmaxf(acc[e], 0.f), sc); \
                const int s_ = 32 * (T_) + l31; sk[hh * 2048 + s_] = (s_ <= tq) ? f2key(sc) : 0u; } while (0)
            bf16x8v kA[4], kB[4];
            DSA_LDK(kA, 0);
            for (int T = 0;;) {
                if (T + 1 < ntile) DSA_LDK(kB, T + 1);
                DSA_SCORE(kA, T);
                if (++T >= ntile) break;
                if (T + 1 < ntile) DSA_LDK(kA, T + 1);
                DSA_SCORE(kB, T);
                if (++T >= ntile) break;
            }
#undef DSA_LDK
#undef DSA_SCORE
        }
        LDS_WAIT(); asm volatile("" ::: "memory");
        unsigned Tsel[2];
#pragma unroll
        for (int q = 0; q < 2; ++q) {
            const int tq = t0 + q;
            unsigned T = 1u;
            if (tq >= 256) {
                const int nch = (tq >> 6) + 1;
                unsigned key[32];
#pragma unroll
                for (int c = 0; c < 32; ++c) key[c] = (c < nch && c * 64 + F.lane <= tq) ? sk[q * 2048 + c * 64 + F.lane] : 0u;
                T = 0u;
#pragma unroll 1
                for (int bit = 31; bit >= 0; --bit) {
                    const unsigned cand = T | (1u << bit); int cnt = 0;
#pragma unroll
                    for (int c = 0; c < 32; ++c) cnt += __popcll(__ballot(key[c] >= cand));
                    if (cnt >= 256) T = cand;
                }
            }
            Tsel[q] = T;
        }
        const int qsel = l31 >> 4, head = l31 & 15, tq = t0 + qsel;
        const unsigned Tm = qsel ? Tsel[1] : Tsel[0];
        const float slope = exp2f(-0.5f * (float)(head + 1));
        bf16x8v qf[8];
#pragma unroll
        for (int ks = 0; ks < 8; ++ks) qf[ks] = ld_frag(QQ + (m0 + qsel) * DSA_QQ + head * 128 + 16 * ks + 8 * hh);
        f32x16v oT[4];
#pragma unroll
        for (int c = 0; c < 4; ++c)
#pragma unroll
            for (int e = 0; e < 16; ++e) oT[c][e] = 0.f;
        float mrun = -INFINITY, lrun = 0.f;
        const unsigned voff = (unsigned)(l31 * 32 + 8 * hh);
#define DSA_LDK2(kd, T_) do { const bf16* kr_ = KTd + ((size_t)b * 64 + (T_)) * 4096;   _Pragma("unroll") for (int ks = 0; ks < 8; ++ks) kd[ks] = ld_frag(kr_ + ks * 512 + F.lane * 8); } while (0)
#define DSA_LDVH(vd, T_, s2_) do { const bf16* vu_ = VT + ((size_t)b * 64 + (T_)) * 4096;   _Pragma("unroll") for (int c = 0; c < 4; ++c) vd[c] = ld_frag(vu_ + c * 1024 + 16 * (s2_) + voff); } while (0)
        {
            bf16x8v kf[8], v0[4], v1[4];
            DSA_LDK2(kf, 0);
#pragma unroll 1
            for (int T = 0; T < ntile; ++T) {
                const int tb = 32 * T;
                DSA_LDVH(v0, T, 0); DSA_LDVH(v1, T, 1);
                f32x16v acc;
#pragma unroll
                for (int e = 0; e < 16; ++e) acc[e] = 0.f;
#pragma unroll
                for (int ks = 0; ks < 8; ++ks) acc = __builtin_amdgcn_mfma_f32_32x32x16_bf16(kf[ks], qf[ks], acc, 0, 0, 0);
                if (T + 1 < ntile) DSA_LDK2(kf, T + 1);
                asm volatile("" ::: "memory");
                float tmax = -INFINITY;
#pragma unroll
                for (int e4 = 0; e4 < 4; ++e4) { if (e4 == 2) asm volatile("" ::: "memory"); const int ko4 = 16 * (e4 >> 1) + 8 * hh + 4 * (e4 & 1); const v4u k4 = *(const LAS v4u*)(sk + qsel * 2048 + tb + ko4);
#pragma unroll
                    for (int i = 0; i < 4; ++i) { const int e = 4 * e4 + i; const int s_ = tb + ko4 + i; const unsigned kk = i == 0 ? k4.x : (i == 1 ? k4.y : (i == 2 ? k4.z : k4.w));
                        const float lg = (kk >= Tm) ? acc[e] * 0.08838834764831845f - slope * (float)(tq - s_) : -INFINITY; acc[e] = lg; tmax = fmaxf(tmax, lg); } }
                tmax = fmaxf(tmax, __shfl_xor(tmax, 32));
                const float mnew = fmaxf(mrun, tmax), msub = (mnew == -INFINITY) ? 0.f : mnew; const float alpha = __expf(mrun - msub); mrun = mnew;
                float ps = 0.f;
#pragma unroll
                for (int e = 0; e < 16; ++e) { const float p = __expf(acc[e] - msub); acc[e] = p; ps += p; }
                lrun = lrun * alpha + ps;
#pragma unroll
                for (int c = 0; c < 4; ++c)
#pragma unroll
                    for (int e = 0; e < 16; ++e) oT[c][e] *= alpha;
                asm volatile("" ::: "memory");
#pragma unroll
                for (int s2 = 0; s2 < 2; ++s2) {
                    const bf16x8v pb = pack_frag(acc[8 * s2], acc[8 * s2 + 1], acc[8 * s2 + 2], acc[8 * s2 + 3], acc[8 * s2 + 4], acc[8 * s2 + 5], acc[8 * s2 + 6], acc[8 * s2 + 7]);
#pragma unroll
                    for (int c = 0; c < 4; ++c) oT[c] = __builtin_amdgcn_mfma_f32_32x32x16_bf16(s2 == 0 ? v0[c] : v1[c], pb, oT[c], 0, 0, 0); }
            }
        }
#undef DSA_LDK2
#undef DSA_LDVH
#undef DSA_TILE
        lrun += __shfl_xor(lrun, 32);
        const float inv = 1.0f / lrun;
        const int lz = opq(lane_id());
        bf16* orow = O + (m0 + ((lz & 31) >> 4)) * D + (lz & 15) * 128 + 4 * (lz >> 5);
#pragma unroll
        for (int c = 0; c < 4; ++c)
#pragma unroll
            for (int r4 = 0; r4 < 4; ++r4) { v2u w; w.x = pg8::cvt_pk_bf16(oT[c][4 * r4] * inv, oT[c][4 * r4 + 1] * inv); w.y = pg8::cvt_pk_bf16(oT[c][4 * r4 + 2] * inv, oT[c][4 * r4 + 3] * inv);
                *(GAS v2u*)(orow + 32 * c + 8 * r4) = w; }
        LDS_WAIT(); asm volatile("" ::: "memory");
    }
}
#ifndef DIL_OLD_KIND
#define DIL_OLD_KIND 2
#endif
#define GRID_BAR() xcd_barrier(bar)
struct Args { const float* in[26]; float* out; unsigned char* ws; };
template <int L>
__device__ __forceinline__ void layer_fwd(Frame& F, const Args& args, const XcdBarrier& bar) {
    unsigned char* ws = args.ws;
    const float* x_in = args.in[0];
    float* out = args.out;
    float* MOD = (float*)(ws + WS_MOD);
    bf16* H = (bf16*)(ws + WS_H);
    bf16* PROJ = (bf16*)(ws + WS_PROJ);
    bf16* OB = (bf16*)(ws + WS_O);
    bf16* KT = (bf16*)(ws + WS_KT); bf16* KI = (bf16*)(ws + WS_KI);
    bf16* VT = (bf16*)(ws + WS_VT); float* LSE = (float*)(ws + WS_LSE); bf16* VTD = (bf16*)(ws + WS_VTD);
    bf16* HID = (bf16*)(ws + WS_BIG);
    bf16* LAT = (bf16*)(ws + WS_LAT); bf16* QL = (bf16*)(ws + WS_QL); bf16* KVL = (bf16*)(ws + WS_KVL); bf16* KV = (bf16*)(ws + WS_KV);
    bf16* QQ = (bf16*)(ws + WS_QQ);
    {
        constexpr int l = L, kind = L % 3, j = L / 3;
        const float* modl = MOD + (size_t)l * 8 * 12288;
        const float* xcur = (l == 0) ? x_in : out;
        norm_phase(F, xcur, args.in[4] + l * D, modl, 0, 2048, H);
#if PROBE == 4
        norm_phase(F, xcur, args.in[4] + l * D, modl, 0, 2048, H);
#endif
        GRID_BAR();
        {
            const bf16* Wt = kind == 0 ? (const bf16*)(ws + WS_SWA_IN_T) + (size_t)j * SWA_IN * D : (kind == 1 ? (const bf16*)(ws + WS_DSA_IN_T) : (const bf16*)(ws + WS_DIL_IN_T));
            const int Nin = kind == 0 ? SWA_IN : (kind == 1 ? DSA_INP : DIL_IN);
            pg8::Gemm g{H, Wt, M, Nin, D}; pg8::StaticOrder So; So.init(M, Nin, F.G, (int)blockIdx.x);
            if constexpr (kind == DIL_OLD_KIND) {
            pg8::EpiQKVold E{PROJ, Nin, VT, kind == 0 ? 16 : (kind == 1 ? 1 : 6), kind == 0 ? 9 : 5, S};
            pg8::gemm_phase<pg8::EpiQKVold, pg8::StaticOrder, true, true>(F.lds + RING_OFF, g, So, E, F.wave);
            } else {
            pg8::EpiQKV E{PROJ, Nin, VT, kind == 0 ? 16 : (kind == 1 ? 1 : 6), kind == 0 ? 9 : 5, S};
            pg8::gemm_phase<pg8::EpiQKV, pg8::StaticOrder, true, true>(F.lds + RING_OFF, g, So, E, F.wave);
            }
        }
        GRID_BAR();
        if constexpr (kind == 0) {
            if constexpr (DIL_OLD_KIND == 0) {
            qknorm_old<0>(F, PROJ, SWA_IN, args.in[9] + j * 64, args.in[10] + j * 64);
            GRID_BAR();
            band_attn_old<8, true>(F, PROJ, SWA_IN, 0, 2048, VT, 0, OB, D, 0, nullptr, args.in[11] + j * 32, 32);
            } else {
            qknorm_phase<0>(F, PROJ, SWA_IN, args.in[9] + j * 64, args.in[10] + j * 64, KT);
            GRID_BAR();
            band_attn_mfma<8, true>(F, PROJ, SWA_IN, 0, KT, VT, 0, OB, D, 0, nullptr, args.in[11] + j * 32, 32);
            }
#if PROBE == 3
            band_attn_mfma<8, true>(F, PROJ, SWA_IN, 0, KT, VT, 0, OB, D, 0, nullptr, args.in[11] + j * 32, 32);
#endif
        } else if constexpr (kind == 1) {
            dsa_latnorm_phase(F, LAT, QL, KVL, args.in[14], args.in[15], KI);
            GRID_BAR();
            {
                pg8::Gemm g{QL, (const bf16*)(ws + WS_DSA_UQ_T), M, DSA_QQ, 512}; pg8::StaticOrder So; So.init(M, DSA_QQ, F.G, (int)blockIdx.x);
                pg8::EpiBf16S<0> E{QQ, DSA_QQ};
                pg8::gemm_phase<pg8::EpiBf16S<0>, pg8::StaticOrder, true, true>(F.lds + RING_OFF, g, So, E, F.wave);
            }
            __syncthreads();
            {
                pg8::Gemm g{KVL, (const bf16*)(ws + WS_DSA_UKV_T), M, 256, 256}; pg8::StaticOrder So; So.init(M, 256, F.G, (int)blockIdx.x);
                pg8::EpiKVd E{KV, 256, VTD, S};
                pg8::gemm_phase<pg8::EpiKVd, pg8::StaticOrder, true, true>(F.lds + RING_OFF, g, So, E, F.wave);
            }
            GRID_BAR();
            dsa_qknorm(F, QQ, KV, args.in[19], args.in[20], KT);
            GRID_BAR();
            dsa_fused(F, LAT, QQ, KT, KI, VTD, OB, KV);
#if PROBE == 2
            dsa_fused(F, LAT, QQ, KT, KI, VTD, OB, KV);
#endif
        } else {
            if constexpr (DIL_OLD_KIND == 2) {
            qknorm_old<2>(F, PROJ, DIL_IN, args.in[23], args.in[24]);
            GRID_BAR();
#pragma unroll 1
            for (int gi = 0; gi < 3; ++gi)
                band_attn_old<4, false>(F, PROJ, DIL_IN, gi * 1536, gi * 1536 + 1024, VT + (size_t)gi * 8 * 4 * 64 * S, 2 * gi, PROJ, DIL_IN, gi * 1536, LSE + (size_t)gi * M * 16, nullptr, 16);
            } else {
            qknorm_phase<2>(F, PROJ, DIL_IN, args.in[23], args.in[24], KT);
            GRID_BAR();
#pragma unroll 1
            for (int gi = 0; gi < 3; ++gi)
                band_attn_mfma<4, false>(F, PROJ, DIL_IN, gi * 1536, KT + (size_t)gi * 8 * 4 * 64 * S, VT + (size_t)gi * 8 * 4 * 64 * S, 2 * gi, PROJ, DIL_IN, gi * 1536, LSE + (size_t)gi * M * 16, nullptr, 16);
            }
            GRID_BAR();
            dil_combine(F, PROJ, LSE, OB);
        }
        GRID_BAR();
        {
            const bf16* Wt = kind == 0 ? (const bf16*)(ws + WS_SWA_OUT_T) + (size_t)j * D * D : (kind == 1 ? (const bf16*)(ws + WS_DSA_OUT_T) : (const bf16*)(ws + WS_DIL_OUT_T));
            const int Ko = kind == 2 ? 1024 : D;
            pg8::Gemm g{OB, Wt, M, D, Ko}; pg8::StaticOrder So; So.init(M, D, F.G, (int)blockIdx.x);
            pg8::EpiResGate E{xcur, out, D, modl + 4096, 12288, S};
            pg8::gemm_phase<pg8::EpiResGate, pg8::StaticOrder, true, true>(F.lds + RING_OFF, g, So, E, F.wave);
        }
        GRID_BAR();
        norm_phase(F, out, args.in[5] + l * D, modl, 6144, 8192, H);
#if PROBE == 4
        norm_phase(F, out, args.in[5] + l * D, modl, 6144, 8192, H);
#endif
        GRID_BAR();
        {
            pg8::Gemm g{H, (const bf16*)(ws + WS_W1T) + (size_t)l * FF * D, M, FF, D}; pg8::StaticOrder So; So.init(M, FF, F.G, (int)blockIdx.x);
            pg8::EpiBf16S<1> E{HID, FF};
            pg8::gemm_phase<pg8::EpiBf16S<1>, pg8::StaticOrder, true, true>(F.lds + RING_OFF, g, So, E, F.wave);
#if PROBE == 5
            __syncthreads();
            pg8::gemm_phase<pg8::EpiBf16S<1>, pg8::StaticOrder, true, true>(F.lds + RING_OFF, g, So, E, F.wave);
#endif
        }
        GRID_BAR();
        {
            pg8::Gemm g{HID, (const bf16*)(ws + WS_W2T) + (size_t)l * D * FF, M, D, FF}; pg8::StaticOrder So; So.init(M, D, F.G, (int)blockIdx.x);
            pg8::EpiResGate E{out, out, D, modl + 10240, 12288, S};
            pg8::gemm_phase<pg8::EpiResGate, pg8::StaticOrder, true, true>(F.lds + RING_OFF, g, So, E, F.wave);
        }
        GRID_BAR();
        }
}
__global__ void __launch_bounds__(NT, 2) fwd_kernel(Args args) {
    extern __shared__ __attribute__((aligned(16))) unsigned char lds[];
    Frame F;
    F.lds = (LAS unsigned char*)lds;
    F.wave = __builtin_amdgcn_readfirstlane((int)threadIdx.x >> 6); F.lane = lane_id(); F.tid = F.wave * 64 + F.lane;
    F.G = gridDim.x; F.gw = blockIdx.x * NWAVES + F.wave; F.NGW = F.G * NWAVES;
    unsigned char* ws = args.ws;
    unsigned* ctl = (unsigned*)(ws + WS_CTL);
    for (int u = F.tid; u < (LDS_BYTES - LDSCTL_OFF) / 4; u += NT) ((LAS unsigned*)(F.lds + LDSCTL_OFF))[u] = 0u;
    __syncthreads();
    XcdBarrier bar = xcd_barrier_post(ctl + CW_BAR, (volatile LAS unsigned*)(F.lds + MISC_OFF) + 8, F.wave);

    float* MOD = (float*)(ws + WS_MOD);

    p0_ada(F, args.in[1], args.in[2], args.in[3], MOD);
    __syncthreads();
    p0_weights(F, args.in, ws);
#if PROBE == 1
    __syncthreads(); p0_ada(F, args.in[1], args.in[2], args.in[3], MOD);
    __syncthreads();
    p0_weights(F, args.in, ws);
#endif
    GRID_BAR();

    layer_fwd<0>(F, args, bar);
    layer_fwd<1>(F, args, bar);
    layer_fwd<2>(F, args, bar);
    layer_fwd<3>(F, args, bar);
}

extern "C" void kernel_launch(void* const* d_in, const int* in_sizes, int n_in, void* d_out, int out_size, void* d_ws, size_t ws_size, hipStream_t stream) {
    static int grid = 0;
    if (grid == 0) {
        if (n_in != 26 || in_sizes[0] != M * D || out_size != M * D || ws_size < WS_END) { fprintf(stderr, "kernel_launch: unexpected shapes / workspace (n_in %d, ws %zu)\n", n_in, ws_size); grid = -1; return; }
        int dev = 0, cus = 0, per_cu = 0;
        if (hipGetDevice(&dev) != hipSuccess || hipDeviceGetAttribute(&cus, hipDeviceAttributeMultiprocessorCount, dev) != hipSuccess) { grid = -1; return; }
        if (hipFuncSetAttribute((const void*)fwd_kernel, hipFuncAttributeMaxDynamicSharedMemorySize, LDS_BYTES) != hipSuccess) { grid = -1; return; }
        if (hipOccupancyMaxActiveBlocksPerMultiprocessor(&per_cu, (const void*)fwd_kernel, NT, LDS_BYTES) != hipSuccess || per_cu < 1) { fprintf(stderr, "kernel_launch: occupancy query reports %d\n", per_cu); }
        (void)hipGetLastError();
        grid = cus;
    }
    if (grid < 0) return;
    if (hipMemsetAsync((char*)d_ws + WS_CTL, 0, CTL_ZERO_BYTES, stream) != hipSuccess) return;
    Args a{};
    for (int i = 0; i < 26; ++i) a.in[i] = (const float*)d_in[i];
    a.out = (float*)d_out; a.ws = (unsigned char*)d_ws;
    hipLaunchKernelGGL(fwd_kernel, dim3(grid), dim3(NT), LDS_BYTES, stream, a);
}
```

```cpp
#include <hip/hip_runtime.h>
#include <cstdio>
#include <cstdint>
#include <cmath>
#ifndef PROBE
#define PROBE 0
#endif
#ifndef VT_TILED_MASK
#define VT_TILED_MASK 3
#endif
namespace pg8 {
#define PG8_LAS __attribute__((address_space(3)))
typedef unsigned short bf16_t;
typedef short bf16x8 __attribute__((ext_vector_type(8)));
typedef float f32x4 __attribute__((ext_vector_type(4)));
typedef unsigned u32x4 __attribute__((ext_vector_type(4)));
constexpr int BM = 256, BK = 64, HALF = 128, HTB = HALF * BK * 2  , STAGE_BYTES = 8 * HTB, NXCD = 8, WGM = 8;

__host__ __device__ __forceinline__ int lds_byte(int r, int c) { const int st = (r >> 4) * 2 + (c >> 5), rr = r & 15, cc = c & 31, ob = rr * 64 + cc * 2; return st * 1024 + (ob ^ (((ob >> 9) & 1) << 5)); }
__host__ __device__ __forceinline__ void stage_rc(int b, int& R, int& C) { const int st = b / 1024, sb = b % 1024, swz = sb ^ (((sb >> 9) & 1) << 5); R = (st >> 1) * 16 + swz / 64; C = (st & 1) * 32 + (swz % 64) / 2; }
__host__ __device__ __forceinline__ int perm32(int rho) { const int n = rho >> 4, i = rho & 15; return 8 * (i >> 2) + 4 * n + (i & 3); }

struct Unit { int pm, pn; };
struct Gemm { const bf16_t* A; const bf16_t* Bt; int M, N, K; };

struct StaticOrder {
    int nM, nN, nwg, G, c;
    __host__ __device__ void init(int M, int N, int G_, int c_) { nM = M / BM; nN = N / BM; nwg = nM * nN; G = G_; c = c_; }
    __host__ __device__ bool next(int i, Unit& u) const {
        const long L = (long)i * G + c; if (L >= nwg) return false;
        int wgid = (int)L; { const int q = nwg / NXCD, r = nwg % NXCD, xcd = wgid % NXCD, off = wgid / NXCD; wgid = (xcd < r ? xcd * (q + 1) : r * (q + 1) + (xcd - r) * q) + off; }
        const int nig = WGM * nN, gid = wgid / nig, fm = gid * WGM, gsz = (nM - fm) < WGM ? (nM - fm) : WGM;
        u.pm = fm + ((wgid % nig) % gsz); u.pn = (wgid % nig) / gsz; return true;
    }
    __device__ __forceinline__ void a_ready(const Unit&) const {}
    __device__ __forceinline__ void done(const Unit&) const {}
};
__device__ __forceinline__ unsigned cvt_pk_bf16(float lo, float hi) { unsigned r; asm volatile("v_cvt_pk_bf16_f32 %0, %1, %2" : "=v"(r) : "v"(lo), "v"(hi)); return r; }
typedef float f32x2 __attribute__((ext_vector_type(2)));
template <int ACT  > struct EpiBf16S {
    static constexpr bool PERM = true, AFTER_DRAIN = false;
    bf16_t* O; int ldc;
    __device__ __forceinline__ void operator()(const f32x4 (&acc)[2][2][4][2], const Unit& u, int wr, int wc, int fr, int fq) const {
        const int row0 = u.pm * BM + wr * 64 + fr, col0 = u.pn * BM + wc * 32 + 8 * fq;
#pragma unroll
        for (int ai = 0; ai < 2; ++ai)
#pragma unroll
            for (int m = 0; m < 4; ++m) { bf16_t* rowp = O + (size_t)(row0 + ai * HALF + m * 16) * ldc + col0;
#pragma unroll
                for (int bj = 0; bj < 2; ++bj) { f32x4 v0 = acc[ai][bj][m][0], v1 = acc[ai][bj][m][1];
                    if (ACT == 1) {
#pragma unroll
                        for (int e = 0; e < 4; ++e) { const float a = fmaxf(v0[e], 0.f), b = fmaxf(v1[e], 0.f); v0[e] = a * a; v1[e] = b * b; } }
                    u32x4 w; w.x = cvt_pk_bf16(v0[0], v0[1]); w.y = cvt_pk_bf16(v0[2], v0[3]); w.z = cvt_pk_bf16(v1[0], v1[1]); w.w = cvt_pk_bf16(v1[2], v1[3]);
                    *(u32x4*)(rowp + bj * HALF) = w; } }
    }
};
template <bool BASE_BF16, bool OUT_BF16>
struct EpiResGate {
    static constexpr bool PERM = false, AFTER_DRAIN = false;
    const void* base; void* out; int ldc; const float* gate; int gate_bstride; int rows_per_batch;
    __device__ __forceinline__ void operator()(const f32x4 (&acc)[2][2][4][2], const Unit& u, int wr, int wc, int fr, int fq) const {
        typedef unsigned u32x2 __attribute__((ext_vector_type(2)));
        const int row0 = u.pm * BM + wr * 64 + fr, col0 = u.pn * BM + wc * 32 + 4 * fq;
        const float* gp = gate + (size_t)((u.pm * BM) / rows_per_batch) * gate_bstride + col0;
        f32x4 gv[2][2];
#pragma unroll
        for (int bj = 0; bj < 2; ++bj)
#pragma unroll
            for (int n = 0; n < 2; ++n) gv[bj][n] = *(const f32x4*)(gp + bj * HALF + n * 16);
#pragma unroll
        for (int ai = 0; ai < 2; ++ai)
#pragma unroll
            for (int m = 0; m < 4; ++m) { const size_t off = (size_t)(row0 + ai * HALF + m * 16) * ldc + col0;
#pragma unroll
                for (int bj = 0; bj < 2; ++bj)
#pragma unroll
                    for (int n = 0; n < 2; ++n) { const size_t o = off + bj * HALF + n * 16; f32x4 bs;
                        if (BASE_BF16) { const u32x2 w = *(const u32x2*)((const bf16_t*)base + o); bs[0] = __uint_as_float(w.x << 16); bs[1] = __uint_as_float(w.x & 0xffff0000u); bs[2] = __uint_as_float(w.y << 16); bs[3] = __uint_as_float(w.y & 0xffff0000u); }
                        else bs = *(const f32x4*)((const float*)base + o);
                        const f32x4 r = bs + gv[bj][n] * acc[ai][bj][m][n];
                        if (OUT_BF16) { u32x2 w; w.x = cvt_pk_bf16(r[0], r[1]); w.y = cvt_pk_bf16(r[2], r[3]); *(u32x2*)((bf16_t*)out + o) = w; }
                        else *(f32x4*)((float*)out + o) = r; } }
    }
};
__device__ __forceinline__ int kperm5e(int i) { return (i & ~12) | ((i & 4) << 1) | ((i & 8) >> 1); }
struct EpiQKV {
    static constexpr bool PERM = true, AFTER_DRAIN = false;
    bf16_t* O; int ldc; bf16_t* VT; bf16_t* KT; int vmod, vres, kres, nqu; int S_; const float* qn; const float* kn; PG8_LAS float* xch; int normed;
    __device__ __forceinline__ void operator()(const f32x4 (&acc)[2][2][4][2], const Unit& u, int wr, int wc, int fr, int fq) const {
        const int row0 = u.pm * BM + wr * 64 + fr;
        const int uq = u.pn % vmod, gi = u.pn / vmod, dsh = 2 * gi;
        if (normed && uq == vres) {
            const int b = (u.pm * BM) / S_;
            bf16_t* vb = VT + ((size_t)gi * 8 + b) * 4 * 64 * S_;
            if (!((VT_TILED_MASK >> gi) & 1)) {
                const unsigned lane_off = (unsigned)((wc * 32 + 8 * fq) * S_);
#pragma unroll
                for (int ai = 0; ai < 2; ++ai)
#pragma unroll
                    for (int m = 0; m < 4; ++m) { const int t = (row0 + ai * HALF + m * 16) & (S_ - 1); const unsigned voff = lane_off + (unsigned)((t & ((1 << dsh) - 1)) * (S_ >> dsh) + (t >> dsh));
#pragma unroll
                        for (int bj = 0; bj < 2; ++bj)
#pragma unroll
                            for (int n = 0; n < 2; ++n)
#pragma unroll
                                for (int e = 0; e < 4; ++e) { bf16_t* vu = vb + (size_t)(bj * HALF + 4 * n + e) * S_; const unsigned w = cvt_pk_bf16(acc[ai][bj][m][n][e], 0.f); vu[voff] = (bf16_t)(w & 0xffffu); }
                        asm volatile("" ::: "memory"); }
                return;
            }
            const unsigned lane_off = (unsigned)((wc >> 1) * (64 * S_) + ((wc & 1) * 32 + 8 * fq) * 32);
#pragma unroll
            for (int ai = 0; ai < 2; ++ai)
#pragma unroll
                for (int m = 0; m < 4; ++m) { const int t = (row0 + ai * HALF + m * 16) & (S_ - 1); const int uu = t >> dsh, rr = t & ((1 << dsh) - 1);
                    const unsigned voff = lane_off + (unsigned)(rr * ((S_ >> dsh) * 64) + (uu >> 5) * 2048 + (uu & 31));
#pragma unroll
                    for (int bj = 0; bj < 2; ++bj)
#pragma unroll
                        for (int n = 0; n < 2; ++n)
#pragma unroll
                            for (int e = 0; e < 4; ++e) { bf16_t* vu = vb + (size_t)(bj * 2) * (64 * S_) + (4 * n + e) * 32;
                                const unsigned w = cvt_pk_bf16(acc[ai][bj][m][n][e], 0.f); vu[voff] = (bf16_t)(w & 0xffffu); }
                    asm volatile("" ::: "memory"); }
            return;
        }
        const int col0 = u.pn * BM + wc * 32 + 8 * fq;
        const bool isq = normed && uq < nqu, isk = normed && uq == kres;
        if (!isq && !isk) {
#pragma unroll
            for (int ai = 0; ai < 2; ++ai)
#pragma unroll
                for (int m = 0; m < 4; ++m) { bf16_t* rowp = O + (size_t)(row0 + ai * HALF + m * 16) * ldc + col0;
#pragma unroll
                    for (int bj = 0; bj < 2; ++bj) { const f32x4 v0 = acc[ai][bj][m][0], v1 = acc[ai][bj][m][1];
                        u32x4 w; w.x = cvt_pk_bf16(v0[0], v0[1]); w.y = cvt_pk_bf16(v0[2], v0[3]); w.z = cvt_pk_bf16(v1[0], v1[1]); w.w = cvt_pk_bf16(v1[2], v1[3]);
                        *(u32x4*)(rowp + bj * HALF) = w; } }
            return;
        }
        float ps[2][4][2];
        int xoff = ((wr * 64 + fr) * 2) * 4 + wc; asm volatile("" : "+v"(xoff));
        PG8_LAS float* xl = xch + xoff;
#pragma unroll
        for (int ai = 0; ai < 2; ++ai)
#pragma unroll
            for (int m = 0; m < 4; ++m)
#pragma unroll
                for (int bj = 0; bj < 2; ++bj) { const f32x4 a = acc[ai][bj][m][0], c = acc[ai][bj][m][1];
                    float s = (a[0] * a[0] + a[1] * a[1]) + (a[2] * a[2] + a[3] * a[3]) + (c[0] * c[0] + c[1] * c[1]) + (c[2] * c[2] + c[3] * c[3]);
                    s += __shfl_xor(s, 16); s += __shfl_xor(s, 32); ps[ai][m][bj] = s;
                    if (fq == 0) xl[(ai * HALF + m * 16) * 8 + bj * 4] = s; }
        asm volatile("s_waitcnt lgkmcnt(0)" ::: "memory"); __builtin_amdgcn_s_barrier(); asm volatile("" ::: "memory");
        const float* gp = (isq ? qn : kn) + gi * 64 + (wc & 1) * 32 + 8 * fq;
        const f32x4 g0 = *(const f32x4*)gp, g1 = *(const f32x4*)(gp + 4);
        const int b = (u.pm * BM) / S_;
        const PG8_LAS float* xp = xl + ((wc ^ 1) - wc);
#pragma unroll
        for (int ai = 0; ai < 2; ++ai)
#pragma unroll
            for (int m = 0; m < 4; ++m) { const int rl = ai * HALF + wr * 64 + m * 16 + fr, row = u.pm * BM + rl;
#pragma unroll
                for (int bj = 0; bj < 2; ++bj) {
                    const float tot = ps[ai][m][bj] + xp[(ai * HALF + m * 16) * 8 + bj * 4];
                    const float rs = 1.0f / sqrtf(tot * (1.f / 64.f) + 1e-6f);
                    const f32x4 v0 = acc[ai][bj][m][0] * rs * g0, v1 = acc[ai][bj][m][1] * rs * g1;
                    u32x4 w; w.x = cvt_pk_bf16(v0[0], v0[1]); w.y = cvt_pk_bf16(v0[2], v0[3]); w.z = cvt_pk_bf16(v1[0], v1[1]); w.w = cvt_pk_bf16(v1[2], v1[3]);
                    if (isq) *(u32x4*)(O + (size_t)row * ldc + col0 + bj * HALF) = w;
                    else { const int t = row & (S_ - 1), uu = t >> dsh, rr = t & ((1 << dsh) - 1), Ssub = S_ >> dsh, kvh = bj * 2 + (wc >> 1), d0 = (wc & 1) * 32 + 8 * fq;
                        const size_t off = ((size_t)((gi * 8 + b) * 4 + kvh)) * (64 * S_) + (size_t)rr * (Ssub * 64) + (size_t)(uu >> 5) * 2048 + (((d0 >> 4) * 2 + ((d0 >> 3) & 1)) * 32 + kperm5e(uu & 31)) * 8;
                        *(u32x4*)(KT + off) = w; } } }
    }
};
struct EpiQd {
    static constexpr bool PERM = true, AFTER_DRAIN = false;
    bf16_t* O; int ldc; const float* qn; PG8_LAS float* xch;
    __device__ __forceinline__ void operator()(const f32x4 (&acc)[2][2][4][2], const Unit& u, int wr, int wc, int fr, int fq) const {
        const int row0 = u.pm * BM + wr * 64 + fr, col0 = u.pn * BM + wc * 32 + 8 * fq;
        const bool isq = u.pn < 8;
        int xoff = ((wr * 64 + fr) * 2) * 4; asm volatile("" : "+v"(xoff));
        PG8_LAS float* xl = xch + xoff;
        if (isq) {
#pragma unroll
            for (int ai = 0; ai < 2; ++ai)
#pragma unroll
                for (int m = 0; m < 4; ++m)
#pragma unroll
                    for (int bj = 0; bj < 2; ++bj) { const f32x4 a = acc[ai][bj][m][0], c = acc[ai][bj][m][1];
                        float s = (a[0] * a[0] + a[1] * a[1]) + (a[2] * a[2] + a[3] * a[3]) + (c[0] * c[0] + c[1] * c[1]) + (c[2] * c[2] + c[3] * c[3]);
                        s += __shfl_xor(s, 16); s += __shfl_xor(s, 32);
                        if (fq == 0) xl[(ai * HALF + m * 16) * 8 + bj * 4 + wc] = s; }
            asm volatile("s_waitcnt lgkmcnt(0)" ::: "memory"); __builtin_amdgcn_s_barrier(); asm volatile("" ::: "memory");
        }
        f32x4 g0 = {1.f, 1.f, 1.f, 1.f}, g1 = {1.f, 1.f, 1.f, 1.f};
        if (isq) { const float* gp = qn + wc * 32 + 8 * fq; g0 = *(const f32x4*)gp; g1 = *(const f32x4*)(gp + 4); }
#pragma unroll
        for (int ai = 0; ai < 2; ++ai)
#pragma unroll
            for (int m = 0; m < 4; ++m) { const int rl = ai * HALF + wr * 64 + m * 16 + fr; bf16_t* rowp = O + (size_t)(u.pm * BM + rl) * ldc + col0;
#pragma unroll
                for (int bj = 0; bj < 2; ++bj) {
                    float rs = 1.f;
                    if (isq) { const f32x4 x4 = *(const PG8_LAS f32x4*)(xl + (ai * HALF + m * 16) * 8 + bj * 4); rs = 1.0f / sqrtf(((x4[0] + x4[1]) + (x4[2] + x4[3])) * (1.f / 128.f) + 1e-6f); }
                    const f32x4 v0 = acc[ai][bj][m][0] * rs * g0, v1 = acc[ai][bj][m][1] * rs * g1;
                    u32x4 w; w.x = cvt_pk_bf16(v0[0], v0[1]); w.y = cvt_pk_bf16(v0[2], v0[3]); w.z = cvt_pk_bf16(v1[0], v1[1]); w.w = cvt_pk_bf16(v1[2], v1[3]);
                    *(u32x4*)(rowp + bj * HALF) = w; } }
    }
};
struct EpiKVd {
    static constexpr bool PERM = true, AFTER_DRAIN = false;
    bf16_t* KTd; bf16_t* VT; int S_; const float* kn; PG8_LAS float* xch;
    __device__ __forceinline__ void operator()(const f32x4 (&acc)[2][2][4][2], const Unit& u, int wr, int wc, int fr, int fq) const {
        const int row0 = u.pm * BM + wr * 64 + fr;
        const int b = (u.pm * BM) / S_;
        int xoff = (wr * 64 + fr) * 4; asm volatile("" : "+v"(xoff));
        PG8_LAS float* xl = xch + xoff;
#pragma unroll
        for (int ai = 0; ai < 2; ++ai)
#pragma unroll
            for (int m = 0; m < 4; ++m) { const f32x4 a = acc[ai][0][m][0], c = acc[ai][0][m][1];
                float s = (a[0] * a[0] + a[1] * a[1]) + (a[2] * a[2] + a[3] * a[3]) + (c[0] * c[0] + c[1] * c[1]) + (c[2] * c[2] + c[3] * c[3]);
                s += __shfl_xor(s, 16); s += __shfl_xor(s, 32);
                if (fq == 0) xl[(ai * HALF + m * 16) * 4 + wc] = s; }
        asm volatile("s_waitcnt lgkmcnt(0)" ::: "memory"); __builtin_amdgcn_s_barrier(); asm volatile("" ::: "memory");
        const float* gp = kn + wc * 32 + 8 * fq; const f32x4 g0 = *(const f32x4*)gp, g1 = *(const f32x4*)(gp + 4);
        const int d0 = wc * 32 + 8 * fq;
#pragma unroll
        for (int ai = 0; ai < 2; ++ai)
#pragma unroll
            for (int m = 0; m < 4; ++m) { const int rl = ai * HALF + wr * 64 + m * 16 + fr, t = (u.pm * BM + rl) & (S_ - 1);
                const f32x4 x4 = *(const PG8_LAS f32x4*)(xl + (ai * HALF + m * 16) * 4); const float rs = 1.0f / sqrtf(((x4[0] + x4[1]) + (x4[2] + x4[3])) * (1.f / 128.f) + 1e-6f);
                const f32x4 v0 = acc[ai][0][m][0] * rs * g0, v1 = acc[ai][0][m][1] * rs * g1;
                u32x4 w; w.x = cvt_pk_bf16(v0[0], v0[1]); w.y = cvt_pk_bf16(v0[2], v0[3]); w.z = cvt_pk_bf16(v1[0], v1[1]); w.w = cvt_pk_bf16(v1[2], v1[3]);
                *(u32x4*)(KTd + ((size_t)(b * 64 + (t >> 5)) * 8 + (d0 >> 4)) * 512 + (((d0 >> 3) & 1) * 32 + kperm5e(t & 31)) * 8) = w; }
        asm volatile("" ::: "memory");
        bf16_t* vb = VT + (size_t)b * 128 * S_;
#pragma unroll
        for (int ai = 0; ai < 2; ++ai)
#pragma unroll
            for (int m = 0; m < 4; ++m) { const int t = (row0 + ai * HALF + m * 16) & (S_ - 1);
                const unsigned voff = (unsigned)((t >> 5) * 4096 + (wc * 32 + 8 * fq) * 32 + (t & 31));
#pragma unroll
                for (int n = 0; n < 2; ++n)
#pragma unroll
                    for (int e = 0; e < 4; ++e) { const unsigned w = cvt_pk_bf16(acc[ai][1][m][n][e], 0.f); vb[voff + (4 * n + e) * 32] = (bf16_t)(w & 0xffffu); }
                asm volatile("" ::: "memory"); }
    }
};
template <class Epi, class Sched, bool ALIGN_EPI = false, bool SP2 = false>
__device__ __forceinline__ void gemm_phase(PG8_LAS unsigned char* lds, const Gemm g, const Sched& S, const Epi& E, const int wave_) {
    int ln_; asm volatile("v_mbcnt_lo_u32_b32 %0, -1, 0\n\tv_mbcnt_hi_u32_b32 %0, -1, %0" : "=v"(ln_)); const int tid_ = wave_ * 64 + ln_;
    const int tid = tid_, wid = __builtin_amdgcn_readfirstlane(tid >> 6), lane = tid & 63, wr = wid >> 2, wc = wid & 3, fr = lane & 15, fq = lane >> 4;
    const int K = g.K, nt = K / BK;
    unsigned voffA[2], voffB[2];
#pragma unroll
    for (int i = 0; i < 2; ++i) { int R, C; stage_rc(tid * 16 + i * 8192, R, C); const int Rb = Epi::PERM ? ((R & ~31) + perm32(R & 31)) : R;
        voffA[i] = (unsigned)(R * K + C) * 2u; voffB[i] = (unsigned)(Rb * K + C) * 2u; }
    const size_t kstep = (size_t)(BK * 2);
    const size_t hstep = (size_t)HALF * K * 2;
    const size_t tstep = 2 * hstep;
    const unsigned ldsw = (unsigned)wid * 1024u;
    const int aoff = lds_byte(wr * 64 + fr, fq * 8), boff = lds_byte(wc * 32 + fr, fq * 8);
#define PG8_SA(b, h) (((b) * 2 + (h)) * HTB)
#define PG8_SB(b, h) ((4 + (b) * 2 + (h)) * HTB)
#define PG8_STAGE(bufoff, gbase, voff) do { _Pragma("unroll") for (int _i = 0; _i < 2; ++_i) \
        __builtin_amdgcn_global_load_lds((const unsigned*)((const char*)(gbase) + (voff)[_i]), (PG8_LAS unsigned*)(lds + (bufoff) + ldsw + _i * 8192), 16, 0, 0); } while (0)
#define PG8_LDA(dst, b, h) do { _Pragma("unroll") for (int m = 0; m < 4; ++m) _Pragma("unroll") for (int k = 0; k < 2; ++k) dst[m][k] = *(const PG8_LAS bf16x8*)(lds + PG8_SA(b, h) + aoff + m * 2048 + k * 1024); } while (0)
#define PG8_LDB(dst, b, h) do { _Pragma("unroll") for (int n = 0; n < 2; ++n) _Pragma("unroll") for (int k = 0; k < 2; ++k) dst[n][k] = *(const PG8_LAS bf16x8*)(lds + PG8_SB(b, h) + boff + n * 2048 + k * 1024); } while (0)
#define PG8_MMA(ai, bj, At, Bt) do { __builtin_amdgcn_s_setprio(1); _Pragma("unroll") for (int m = 0; m < 4; ++m) _Pragma("unroll") for (int n = 0; n < 2; ++n) _Pragma("unroll") for (int k = 0; k < 2; ++k) \
        acc[ai][bj][m][n] = __builtin_amdgcn_mfma_f32_16x16x32_bf16(Bt[n][k], At[m][k], acc[ai][bj][m][n], 0, 0, 0); __builtin_amdgcn_s_setprio(0); } while (0)
#define PG8_WAIT_V(n) asm volatile("s_waitcnt vmcnt(" #n ")" ::: "memory")
#define PG8_WAIT_L(n) asm volatile("s_waitcnt lgkmcnt(" #n ")" ::: "memory")
#define PG8_BAR __builtin_amdgcn_s_barrier()
#define PG8_SCHED __builtin_amdgcn_sched_barrier(0)
    Unit cur, nxt; int ui = 0;
    if (!S.next(0, cur)) return;
    f32x4 acc[2][2][4][2];
#pragma unroll
    for (int a = 0; a < 2; ++a)
#pragma unroll
        for (int b = 0; b < 2; ++b)
#pragma unroll
            for (int m = 0; m < 4; ++m)
#pragma unroll
                for (int n = 0; n < 2; ++n) acc[a][b][m][n] = (f32x4){0.f, 0.f, 0.f, 0.f};
    bf16x8 At[4][2], B0[2][2], B1[2][2];
    const char* cA = (const char*)g.A + (size_t)cur.pm * tstep; const char* cB = (const char*)g.Bt + (size_t)cur.pn * tstep;
    S.a_ready(cur);
    if constexpr (SP2) {
        PG8_STAGE(PG8_SB(0, 0), cB, voffB); PG8_STAGE(PG8_SB(0, 1), cB + hstep, voffB); PG8_STAGE(PG8_SA(0, 0), cA, voffA); PG8_STAGE(PG8_SA(0, 1), cA + hstep, voffA);
        if (wr == 1) PG8_BAR;
        PG8_WAIT_V(2); PG8_BAR;
        PG8_STAGE(PG8_SB(1, 0), cB + kstep, voffB); PG8_STAGE(PG8_SA(1, 0), cA + kstep, voffA); PG8_STAGE(PG8_SB(1, 1), cB + hstep + kstep, voffB);
        PG8_WAIT_V(6); PG8_BAR;
    } else {
        PG8_STAGE(PG8_SB(0, 0), cB, voffB); PG8_STAGE(PG8_SA(0, 0), cA, voffA); PG8_STAGE(PG8_SB(0, 1), cB + hstep, voffB); PG8_STAGE(PG8_SA(0, 1), cA + hstep, voffA);
        if (wr == 1) PG8_BAR;
        PG8_WAIT_V(4); PG8_BAR;
        PG8_STAGE(PG8_SB(1, 0), cB + kstep, voffB); PG8_STAGE(PG8_SA(1, 0), cA + kstep, voffA); PG8_STAGE(PG8_SB(1, 1), cB + hstep + kstep, voffB);
        PG8_WAIT_V(6); PG8_BAR;
    }
    for (;;) {
        const bool has_next = S.next(ui + 1, nxt);
        const char* nA = has_next ? (const char*)g.A + (size_t)nxt.pm * tstep : cA; const char* nB = has_next ? (const char*)g.Bt + (size_t)nxt.pn * tstep : cB;
#pragma unroll 1
        for (int t = 0; t < nt; t += 2) {
            const bool last = (t == nt - 2);
            const char* a1 = cA + (size_t)(t + 1) * kstep;
            const char* a2 = last ? nA : cA + (size_t)(t + 2) * kstep; const char* b2 = last ? nB : cB + (size_t)(t + 2) * kstep;
            const char* a3 = a2 + kstep; const char* b3 = b2 + kstep;
            if (last && has_next) S.a_ready(nxt);
            if constexpr (SP2) {
            PG8_LDB(B0, 0, 0); PG8_LDB(B1, 0, 1); PG8_SCHED; PG8_LDA(At, 0, 0); PG8_STAGE(PG8_SA(1, 1), a1 + hstep, voffA);
            PG8_WAIT_V(8); PG8_WAIT_L(0); PG8_BAR; PG8_MMA(0, 0, At, B0); PG8_MMA(0, 1, At, B1); PG8_BAR; PG8_SCHED;
            PG8_LDA(At, 0, 1); PG8_STAGE(PG8_SB(0, 0), b2, voffB); PG8_STAGE(PG8_SB(0, 1), b2 + hstep, voffB); PG8_STAGE(PG8_SA(0, 0), a2, voffA);
            PG8_WAIT_V(8); PG8_WAIT_L(0); PG8_BAR; PG8_MMA(1, 0, At, B0); PG8_MMA(1, 1, At, B1); PG8_BAR; PG8_SCHED;
            PG8_LDB(B0, 1, 0); PG8_LDB(B1, 1, 1); PG8_SCHED; PG8_LDA(At, 1, 0); PG8_STAGE(PG8_SA(0, 1), a2 + hstep, voffA);
            PG8_WAIT_V(8); PG8_WAIT_L(0); PG8_BAR; PG8_MMA(0, 0, At, B0); PG8_MMA(0, 1, At, B1); PG8_BAR; PG8_SCHED;
            PG8_LDA(At, 1, 1); PG8_STAGE(PG8_SB(1, 0), b3, voffB); PG8_STAGE(PG8_SB(1, 1), b3 + hstep, voffB); PG8_STAGE(PG8_SA(1, 0), a3, voffA);
            PG8_WAIT_V(8); PG8_WAIT_L(0); PG8_BAR; PG8_MMA(1, 0, At, B0); PG8_MMA(1, 1, At, B1); PG8_BAR; PG8_SCHED;
            } else {
            PG8_LDB(B0, 0, 0); PG8_SCHED; PG8_LDA(At, 0, 0); PG8_STAGE(PG8_SA(1, 1), a1 + hstep, voffA);
            PG8_WAIT_L(8); PG8_BAR; PG8_WAIT_L(0); PG8_MMA(0, 0, At, B0); PG8_BAR; PG8_SCHED;
            PG8_LDB(B1, 0, 1); PG8_STAGE(PG8_SB(0, 0), b2, voffB);
            PG8_BAR; PG8_WAIT_L(0); PG8_MMA(0, 1, At, B1); PG8_BAR;
            PG8_LDA(At, 0, 1); PG8_STAGE(PG8_SA(0, 0), a2, voffA);
            PG8_BAR; PG8_WAIT_L(0); PG8_MMA(1, 0, At, B0); PG8_BAR; PG8_SCHED;
            PG8_STAGE(PG8_SB(0, 1), b2 + hstep, voffB);
            PG8_WAIT_V(6); PG8_BAR; PG8_MMA(1, 1, At, B1); PG8_BAR;
            PG8_LDB(B0, 1, 0); PG8_SCHED; PG8_LDA(At, 1, 0); PG8_STAGE(PG8_SA(0, 1), a2 + hstep, voffA);
            PG8_WAIT_L(8); PG8_BAR; PG8_WAIT_L(0); PG8_MMA(0, 0, At, B0); PG8_BAR; PG8_SCHED;
            PG8_LDB(B1, 1, 1); PG8_STAGE(PG8_SB(1, 0), b3, voffB);
            PG8_BAR; PG8_WAIT_L(0); PG8_MMA(0, 1, At, B1); PG8_BAR;
            PG8_LDA(At, 1, 1); PG8_STAGE(PG8_SA(1, 0), a3, voffA);
            PG8_BAR; PG8_WAIT_L(0); PG8_MMA(1, 0, At, B0); PG8_BAR; PG8_SCHED;
            PG8_STAGE(PG8_SB(1, 1), b3 + hstep, voffB);
            PG8_WAIT_V(6); PG8_BAR; PG8_MMA(1, 1, At, B1); PG8_BAR;
            }
        }
        if constexpr (ALIGN_EPI) { if (wr == 0) PG8_BAR; }
        if constexpr (!Epi::AFTER_DRAIN) { E(acc, cur, wr, wc, fr, fq); S.done(cur); }
        if (!has_next) break;
#pragma unroll
        for (int a = 0; a < 2; ++a)
#pragma unroll
            for (int b = 0; b < 2; ++b)
#pragma unroll
                for (int m = 0; m < 4; ++m)
#pragma unroll
                    for (int n = 0; n < 2; ++n) acc[a][b][m][n] = (f32x4){0.f, 0.f, 0.f, 0.f};
        cur = nxt; cA = nA; cB = nB; ++ui;
        if constexpr (ALIGN_EPI) { if (wr == 1) PG8_BAR; }
    }
    PG8_WAIT_V(0);
    if constexpr (!ALIGN_EPI) { if (wr == 0) PG8_BAR; }
    PG8_BAR;
    if constexpr (Epi::AFTER_DRAIN) { E.fused(acc, cur, wr, wc, fr, fq, lds, wid, lane); S.done(cur); }
#undef PG8_SA
#undef PG8_SB
#undef PG8_STAGE
#undef PG8_LDA
#undef PG8_LDB
#undef PG8_MMA
#undef PG8_WAIT_V
#undef PG8_WAIT_L
#undef PG8_BAR
#undef PG8_SCHED
}
}
constexpr int NWAVES = 8, NT = NWAVES * 64;
constexpr int BATCH = 8, S = 2048, D = 2048, M = BATCH * S, FF = 8192, DEPTH = 4;
constexpr int SWA_IN = 2560, DSA_INP = 1024  , DSA_IN_SRC = 848, DIL_IN = 4608, DSA_QQ = 3072;
constexpr float EPS = 1e-6f;
constexpr size_t MiB = 1u << 20;
constexpr size_t WS_CTL = 0, CTL_ZERO_BYTES = 1 * MiB;
constexpr size_t WS_MOD = 1 * MiB;
constexpr size_t WS_W1T = 4 * MiB, WS_W2T = 132 * MiB;
constexpr size_t WS_SWA_IN_T = 260 * MiB, WS_SWA_OUT_T = 280 * MiB;
constexpr size_t WS_DSA_IN_T = 296 * MiB, WS_DSA_UQ_T = 300 * MiB, WS_DSA_UKV_T = 303 * MiB, WS_DSA_OUT_T = 304 * MiB;
constexpr size_t WS_DIL_IN_T = 312 * MiB, WS_DIL_OUT_T = 330 * MiB;
constexpr size_t WS_H = 334 * MiB;
constexpr size_t WS_BIG = 398 * MiB;
constexpr size_t WS_PROJ = WS_BIG;
constexpr size_t WS_O = WS_BIG + 192 * MiB;
constexpr size_t WS_LAT = WS_BIG, WS_QL = WS_BIG + 32 * MiB, WS_KVL = WS_BIG + 48 * MiB, WS_KV = WS_BIG + 56 * MiB, WS_IDX = WS_BIG + 64 * MiB, WS_NSEL = WS_BIG + 72 * MiB, WS_QQ = WS_BIG + 80 * MiB;
constexpr size_t WS_VT = WS_BIG + 144 * MiB, WS_LSE = WS_BIG + 170 * MiB;
constexpr size_t WS_VTD = WS_BIG + 64 * MiB;
constexpr size_t WS_KT = 654 * MiB, WS_KI = 680 * MiB;
constexpr size_t WS_XB = 684 * MiB;
constexpr size_t WS_END = 748 * MiB;
constexpr int CW_BAR = 4096;
constexpr int RING_OFF = 0, RING_BYTES = 131072;
constexpr int LDSCTL_OFF = RING_BYTES, MISC_OFF = LDSCTL_OFF + 320;
constexpr int XCH_OFF = RING_BYTES + 1024;
constexpr int LDS_BYTES = 147456;

#define GAS __attribute__((address_space(1)))
#define LAS __attribute__((address_space(3)))
typedef unsigned short bf16;
typedef unsigned v4u __attribute__((ext_vector_type(4)));
typedef unsigned v2u __attribute__((ext_vector_type(2)));
typedef float f32x4 __attribute__((ext_vector_type(4)));
#define LDS_WAIT() asm volatile("s_waitcnt lgkmcnt(0)" ::: "memory")
#define VM_WAIT() asm volatile("s_waitcnt vmcnt(0)" ::: "memory")
__device__ __forceinline__ unsigned f2bf(float f) { unsigned u = __builtin_bit_cast(unsigned, f); return (u + 0x7fffu + ((u >> 16) & 1u)) >> 16; }
__device__ __forceinline__ unsigned pk2(float lo, float hi) { return f2bf(lo) | (f2bf(hi) << 16); }
__device__ __forceinline__ float bflo(unsigned w) { return __uint_as_float(w << 16); }
__device__ __forceinline__ float bfhi(unsigned w) { return __uint_as_float(w & 0xffff0000u); }
__device__ __forceinline__ float bf2f(bf16 v) { return __uint_as_float((unsigned)v << 16); }
__device__ __forceinline__ void unpack8(const v4u w, float* f) { f[0] = bflo(w.x); f[1] = bfhi(w.x); f[2] = bflo(w.y); f[3] = bfhi(w.y); f[4] = bflo(w.z); f[5] = bfhi(w.z); f[6] = bflo(w.w); f[7] = bfhi(w.w); }
__device__ __forceinline__ float wave_sum(float v) {
#pragma unroll
    for (int o = 1; o < 64; o <<= 1) v += __shfl_xor(v, o);
    return v;
}
__device__ __forceinline__ float wave_max(float v) {
#pragma unroll
    for (int o = 1; o < 64; o <<= 1) v = fmaxf(v, __shfl_xor(v, o));
    return v;
}
__device__ __forceinline__ int opq(int v) { asm volatile("" : "+v"(v)); return v; }
__device__ __forceinline__ int kperm5(int i) { return (i & ~12) | ((i & 4) << 1) | ((i & 8) >> 1); }
__device__ __forceinline__ int lane_id() { int x; asm volatile("v_mbcnt_lo_u32_b32 %0, -1, 0\n\tv_mbcnt_hi_u32_b32 %0, -1, %0" : "=v"(x)); return x; }
__device__ __forceinline__ void st_wt16(bf16* p, v4u v) { asm volatile("global_store_dwordx4 %0, %1, off sc0 sc1" :: "v"((GAS v4u*)p), "v"(v) : "memory"); }
#define XB_TMO      128
#define XB_XCNT(j)  (256  + 64 * (j))
#define XB_XSUB(j)  (1280 + 64 * (j))
#define XB_XGEN(j)  (2304 + 64 * (j))
#define XB_TOP      3328
#define XB_TOPGEN   3392
#define XCD_BAR_WORDS 3456
#define XB_SPIN_CAP (1u << 18)

__device__ __forceinline__ unsigned xb_ld(unsigned* p)              { return __hip_atomic_load(p, __ATOMIC_RELAXED, __HIP_MEMORY_SCOPE_AGENT); }
__device__ __forceinline__ unsigned xb_add(unsigned* p, unsigned v) { return __hip_atomic_fetch_add(p, v, __ATOMIC_RELAXED, __HIP_MEMORY_SCOPE_AGENT); }
__device__ __forceinline__ unsigned xb_xcc_id() { return (unsigned)__builtin_amdgcn_s_getreg((3 << 11) | 20) & 0xFu; }
#define XB_SPIN(cond, bar) do { unsigned _sp = 0; while (cond) { __builtin_amdgcn_s_sleep(1); \
    if ((++_sp & 255u) == 0u) { if (xb_ld(&(bar)[XB_TMO])) break; if (_sp > XB_SPIN_CAP) { atomicAdd(&(bar)[XB_TMO], 1u); break; } } } } while (0)

struct XcdBarrier {
    unsigned* bar; unsigned x; int w;
    volatile LAS unsigned* st;
};

__device__ __forceinline__ XcdBarrier xcd_barrier_post(unsigned* bar, volatile LAS unsigned* st, int wave) {
    XcdBarrier b; b.bar = bar; b.x = xb_xcc_id(); b.st = st; b.w = wave;
    if (wave == 0 && lane_id() == 0) (void)xb_add(&bar[XB_XCNT(b.x)], 1u);
    return b;
}
__device__ __forceinline__ void xcd_barrier_complete(unsigned* bar, unsigned x, unsigned& nloc, unsigned& nx) {
    const unsigned G = gridDim.x * gridDim.y * gridDim.z;
    unsigned sum, cnt, mine, sp = 0u;
    for (;;) {
        sum = 0u; cnt = 0u; mine = 0u;
#pragma unroll
        for (unsigned j = 0; j < 16; ++j) { const unsigned c = xb_ld(&bar[XB_XCNT(j)]); sum += c; cnt += (c > 0u) ? 1u : 0u; mine = (j == x) ? c : mine; }
        if (sum == G) break;
        __builtin_amdgcn_s_sleep(1);
        if ((++sp & 255u) == 0u) { if (xb_ld(&bar[XB_TMO])) break; if (sp > XB_SPIN_CAP) { atomicAdd(&bar[XB_TMO], 1u); break; } }
    }
    nloc = mine > 0u ? mine : 1u; nx = cnt > 0u ? cnt : 1u;
}

__device__ __forceinline__ void xcd_barrier(const XcdBarrier& b) {
    asm volatile("s_waitcnt vmcnt(0)" ::: "memory");
    __syncthreads();
    if (b.w == 0 && lane_id() == 0) {
        unsigned* bar = b.bar;
        __builtin_amdgcn_s_waitcnt(0);
        unsigned nloc = b.st[0], nx = b.st[1];
        if (nloc == 0u) { xcd_barrier_complete(bar, b.x, nloc, nx); b.st[0] = nloc; b.st[1] = nx; }
        const unsigned old = xb_add(&bar[XB_XSUB(b.x)], 1u);
        const unsigned gen = old / nloc;
        if (old + 1u == (gen + 1u) * nloc) {
            __builtin_amdgcn_fence(__ATOMIC_RELEASE, "agent");
            asm volatile("s_waitcnt vmcnt(0)" ::: "memory");
            const unsigned og = xb_add(&bar[XB_TOP], 1u);
            const unsigned tg = og / nx;
            if (og + 1u == (tg + 1u) * nx) xb_add(&bar[XB_TOPGEN], 1u);
            else XB_SPIN(xb_ld(&bar[XB_TOPGEN]) == tg, bar);
            __builtin_amdgcn_fence(__ATOMIC_ACQUIRE, "agent");
            xb_add(&bar[XB_XGEN(b.x)], 1u);
            asm volatile("s_waitcnt vmcnt(0)" ::: "memory");
        } else {
            XB_SPIN(xb_ld(&bar[XB_XGEN(b.x)]) == gen, bar);
            __builtin_amdgcn_fence(__ATOMIC_ACQUIRE, "agent");
            asm volatile("s_waitcnt vmcnt(0)" ::: "memory");
        }
    }
    __syncthreads();
}
struct Frame {
    LAS unsigned char* lds;
    int tid, lane, wave, G, gw, NGW;
};

__device__ __forceinline__ void p0_ada(const Frame& F0, const float* c, const float* ada_w, const float* ada_b, float* mod) {
    Frame F = F0; F.lane = opq(lane_id()); F.tid = F0.wave * 64 + F.lane;
    LAS float* cond = (LAS float*)(F.lds + RING_OFF);
    LAS float* red = (LAS float*)(F.lds + RING_OFF + 65536);
    for (int i = F.tid; i < 8 * 2048; i += NT) { const int b = i >> 11, k = i & 2047; const float v = c[i]; cond[k * 8 + b] = v / (1.f + __expf(-v)); }
    __syncthreads();
    constexpr int NSLAB = DEPTH * 64;
    for (int slab = blockIdx.x; slab < NSLAB; slab += F.G) {
        const int layer = slab >> 6, col0 = (slab & 63) * 192;
        const float* W = ada_w + (size_t)layer * 2048 * 12288 + col0 + F.lane;
        float acc[3][8];
#pragma unroll
        for (int j = 0; j < 3; ++j)
#pragma unroll
            for (int b = 0; b < 8; ++b) acc[j][b] = 0.f;
        const int k0 = F.wave * 256;
        for (int k = k0; k < k0 + 256; k += 8) {
            float w[8][3];
#pragma unroll
            for (int kk = 0; kk < 8; ++kk)
#pragma unroll
                for (int j = 0; j < 3; ++j) w[kk][j] = W[(size_t)(k + kk) * 12288 + 64 * j];
#pragma unroll
            for (int kk = 0; kk < 8; ++kk) {
                const f32x4 c0 = *(const LAS f32x4*)(cond + (k + kk) * 8), c1 = *(const LAS f32x4*)(cond + (k + kk) * 8 + 4);
#pragma unroll
                for (int j = 0; j < 3; ++j) {
                    acc[j][0] += w[kk][j] * c0[0]; acc[j][1] += w[kk][j] * c0[1]; acc[j][2] += w[kk][j] * c0[2]; acc[j][3] += w[kk][j] * c0[3];
                    acc[j][4] += w[kk][j] * c1[0]; acc[j][5] += w[kk][j] * c1[1]; acc[j][6] += w[kk][j] * c1[2]; acc[j][7] += w[kk][j] * c1[3]; }
            }
        }
#pragma unroll
        for (int j = 0; j < 3; ++j)
#pragma unroll
            for (int b = 0; b < 8; ++b) red[(F.wave * 8 + b) * 192 + j * 64 + F.lane] = acc[j][b];
        __syncthreads();
        for (int o = F.tid; o < 8 * 192; o += NT) { const int b = o / 192, cc = o % 192; float s = 0.f;
#pragma unroll
            for (int w = 0; w < 8; ++w) s += red[(w * 8 + b) * 192 + cc];
            mod[(size_t)(layer * 8 + b) * 12288 + col0 + cc] = s + ada_b[layer * 12288 + col0 + cc]; }
        __syncthreads();
    }
}

__device__ __forceinline__ void p0_transpose_item(const float* W, int K, int Nsrc, int Npad, bf16* WT, int row_off, LAS float* scr, int item, int lane) {
    const int nblk = Npad / 32, kb = item / nblk, nb = item % nblk, k0 = 64 * kb, n0 = 32 * nb;
    const int nc = n0 + (lane & 31); const bool ok = nc < Nsrc;
    float wreg[32];
    const float* wp = W + (size_t)(k0 + (lane >> 5)) * Nsrc + (ok ? nc : 0);
#pragma unroll
    for (int i = 0; i < 32; ++i) wreg[i] = wp[(size_t)(2 * i) * Nsrc];
#pragma unroll
    for (int i = 0; i < 32; ++i) scr[(2 * i + (lane >> 5)) * 33 + (lane & 31)] = ok ? wreg[i] : 0.f;
    LDS_WAIT(); asm volatile("" ::: "memory");
    const int cch = lane & 7;
#pragma unroll
    for (int j = 0; j < 4; ++j) { const int n = (lane >> 3) + 8 * j; const LAS float* s = scr + (8 * cch) * 33 + n;
        v4u o; o.x = pk2(s[0 * 33], s[1 * 33]); o.y = pk2(s[2 * 33], s[3 * 33]); o.z = pk2(s[4 * 33], s[5 * 33]); o.w = pk2(s[6 * 33], s[7 * 33]);
        *(GAS v4u*)(WT + (size_t)(row_off + n0 + n) * K + k0 + 8 * cch) = o; }
    LDS_WAIT(); asm volatile("" ::: "memory");
}
struct TJob { const float* src; bf16* dst; int K, Nsrc, Npad, row_off, items; };
__device__ __forceinline__ void p0_weights(const Frame& F0, const float* const* in, unsigned char* ws) {
    Frame F = F0; F.lane = opq(lane_id()); F.tid = F0.wave * 64 + F.lane;
    LAS float* scr = (LAS float*)(F.lds + RING_OFF + F.wave * 16384);
    constexpr int NJOB = 19;
    for (int it = F.gw; ; it += F.NGW) {
        int r = it; TJob jb; bool found = false;
#pragma unroll
        for (int q = 0; q < NJOB; ++q) {
            TJob t;
            if (q < 4)       t = TJob{in[6] + (size_t)q * D * FF, (bf16*)(ws + WS_W1T) + (size_t)q * FF * D, D, FF, FF, 0, (D / 64) * (FF / 32)};
            else if (q < 8)  t = TJob{in[7] + (size_t)(q - 4) * FF * D, (bf16*)(ws + WS_W2T) + (size_t)(q - 4) * D * FF, FF, D, D, 0, (FF / 64) * (D / 32)};
            else if (q < 10) t = TJob{in[8] + (size_t)(q - 8) * D * SWA_IN, (bf16*)(ws + WS_SWA_IN_T) + (size_t)(q - 8) * SWA_IN * D, D, SWA_IN, SWA_IN, 0, (D / 64) * (SWA_IN / 32)};
            else if (q < 12) t = TJob{in[12] + (size_t)(q - 10) * D * D, (bf16*)(ws + WS_SWA_OUT_T) + (size_t)(q - 10) * D * D, D, D, D, 0, (D / 64) * (D / 32)};
            else if (q == 12) t = TJob{in[13], (bf16*)(ws + WS_DSA_IN_T), D, DSA_IN_SRC, DSA_INP, 0, (D / 64) * (DSA_INP / 32)};
            else if (q == 13) t = TJob{in[16], (bf16*)(ws + WS_DSA_UQ_T), 512, 2048, 2048, 0, (512 / 64) * (2048 / 32)};
            else if (q == 14) t = TJob{in[18], (bf16*)(ws + WS_DSA_UQ_T), 512, 1024, 1024, 2048, (512 / 64) * (1024 / 32)};
            else if (q == 15) t = TJob{in[17], (bf16*)(ws + WS_DSA_UKV_T), 256, 256, 256, 0, (256 / 64) * (256 / 32)};
            else if (q == 16) t = TJob{in[21], (bf16*)(ws + WS_DSA_OUT_T), D, D, D, 0, (D / 64) * (D / 32)};
            else if (q == 17) t = TJob{in[22], (bf16*)(ws + WS_DIL_IN_T), D, DIL_IN, DIL_IN, 0, (D / 64) * (DIL_IN / 32)};
            else              t = TJob{in[25], (bf16*)(ws + WS_DIL_OUT_T), 1024, D, D, 0, (1024 / 64) * (D / 32)};
            if (!found) { if (r < t.items) { jb = t; found = true; } else r -= t.items; }
        }
        if (!found) break;
        p0_transpose_item(jb.src, jb.K, jb.Nsrc, jb.Npad, jb.dst, jb.row_off, scr, r, F.lane);
    }
}

template <bool IN_BF16>
__device__ __forceinline__ void norm_phase(const Frame& F0, const void* x, const float* gain, const float* modl, int sh_off, int sc_off, bf16* H) {
    Frame F = F0; F.lane = opq(lane_id()); F.tid = F0.wave * 64 + F.lane;
    for (int rg = F.gw; rg < M / 8; rg += F.NGW) {
        const int m0 = rg * 8, b = m0 / S;
        const float* mb = modl + (size_t)b * 12288;
        f32x4 A[8], Sh[8];
#pragma unroll
        for (int j = 0; j < 8; ++j) { const int col = 4 * (F.lane + 64 * j); const f32x4 g = *(const f32x4*)(gain + col), sc = *(const f32x4*)(mb + sc_off + col); Sh[j] = *(const f32x4*)(mb + sh_off + col); A[j] = g * (sc + 1.0f); }
        for (int r = 0; r < 8; ++r) {
            f32x4 v[8]; float ss = 0.f;
            if (IN_BF16) { const GAS v2u* xr = (const GAS v2u*)((const bf16*)x + (size_t)(m0 + r) * D) + F.lane;
#pragma unroll
                for (int j = 0; j < 8; ++j) { const v2u w = xr[64 * j]; v[j].x = bflo(w.x); v[j].y = bfhi(w.x); v[j].z = bflo(w.y); v[j].w = bfhi(w.y); } }
            else { const GAS f32x4* xr = (const GAS f32x4*)((const float*)x + (size_t)(m0 + r) * D) + F.lane;
#pragma unroll
                for (int j = 0; j < 8; ++j) v[j] = xr[64 * j]; }
#pragma unroll
            for (int j = 0; j < 8; ++j) ss += (v[j].x * v[j].x + v[j].y * v[j].y) + (v[j].z * v[j].z + v[j].w * v[j].w);
            const float rstd = 1.0f / sqrtf(wave_sum(ss) * (1.f / D) + EPS);
            GAS v2u* o8 = (GAS v2u*)(H + (size_t)(m0 + r) * D) + F.lane;
#pragma unroll
            for (int j = 0; j < 8; ++j) { const f32x4 h = v[j] * rstd * A[j] + Sh[j]; v2u w; w.x = pk2(h.x, h.y); w.y = pk2(h.z, h.w); o8[64 * j] = w; }
        }
    }
}

template <int KIND>
__device__ __forceinline__ void qknorm_phase(const Frame& F0, bf16* P, int pitch, const float* qn, const float* kn, bf16* KT) {
    Frame F = F0; F.lane = opq(lane_id()); F.tid = F0.wave * 64 + F.lane;
    constexpr int NCOLS = KIND == 0 ? 2048 : DIL_IN;
    for (int m = F.gw; m < M; m += F.NGW) {
        bf16* row = P + (size_t)m * pitch;
        for (int c0 = 0; c0 < NCOLS; c0 += 512) {
            const int col = c0 + 8 * F.lane;
            bool act; const float* g;
            if (KIND == 0) { act = true; g = qn + (col & 63); }
            else { const int gi = col / 1536, cl = col - gi * 1536; act = cl < 1024; g = qn + gi * 64 + (col & 63); }
            float f[8]; float ss = 0.f;
            if (act) { const v4u w = *(const GAS v4u*)(row + col); unpack8(w, f);
#pragma unroll
                for (int e = 0; e < 8; ++e) ss += f[e] * f[e]; }
            ss += __shfl_xor(ss, 1); ss += __shfl_xor(ss, 2); ss += __shfl_xor(ss, 4);
            if (act) { const float rstd = 1.0f / sqrtf(ss * (1.f / 64.f) + EPS); const f32x4 g0 = *(const f32x4*)g, g1 = *(const f32x4*)(g + 4);
                v4u o; o.x = pk2(f[0] * rstd * g0.x, f[1] * rstd * g0.y); o.y = pk2(f[2] * rstd * g0.z, f[3] * rstd * g0.w); o.z = pk2(f[4] * rstd * g1.x, f[5] * rstd * g1.y); o.w = pk2(f[6] * rstd * g1.z, f[7] * rstd * g1.w);
                *(GAS v4u*)(row + col) = o; }
        }
    }
    constexpr int NG = KIND == 0 ? 1 : 3;
    for (int it = F.gw; it < NG * 2048; it += F.NGW) {
        const int gi = it >> 11, rem = it & 2047, b = rem >> 8, kvh = (rem >> 6) & 3, rt = rem & 63;
        const int dsh = 2 * gi, Ssub = S >> dsh, tpr = Ssub >> 5, r = rt / tpr, T = rt - r * tpr;
        const int pp = F.lane >> 1, half = F.lane & 1, u = 32 * T + kperm5(pp), t = (u << dsh) + r;
        const int kcol = (KIND == 0 ? 2048 : gi * 1536 + 1024) + kvh * 64 + half * 32;
        const bf16* src = P + ((size_t)b * S + t) * pitch + kcol;
        float f[32]; float ss = 0.f;
#pragma unroll
        for (int c = 0; c < 4; ++c) { const v4u w = *(const GAS v4u*)(src + 8 * c); unpack8(w, f + 8 * c); }
#pragma unroll
        for (int e = 0; e < 32; ++e) ss += f[e] * f[e];
        ss += __shfl_xor(ss, 1);
        const float rstd = 1.0f / sqrtf(ss * (1.f / 64.f) + EPS);
        const float* g = kn + gi * 64 + half * 32;
        bf16* dst = KT + ((size_t)((gi * 8 + b) * 4 + kvh)) * (64 * S) + (size_t)r * (Ssub * 64) + (size_t)T * 2048;
#pragma unroll
        for (int c = 0; c < 4; ++c) { const f32x4 g0 = *(const f32x4*)(g + 8 * c), g1 = *(const f32x4*)(g + 8 * c + 4); const float* x = f + 8 * c;
            v4u o; o.x = pk2(x[0] * rstd * g0.x, x[1] * rstd * g0.y); o.y = pk2(x[2] * rstd * g0.z, x[3] * rstd * g0.w); o.z = pk2(x[4] * rstd * g1.x, x[5] * rstd * g1.y); o.w = pk2(x[6] * rstd * g1.z, x[7] * rstd * g1.w);
            *(GAS v4u*)(dst + (((half * 2 + (c >> 1)) * 2 + (c & 1)) * 32 + pp) * 8) = o;
#ifdef K_INPLACE_TOO
            *(GAS v4u*)((bf16*)src + 8 * c) = o;
#endif
            }
    }
}

template <int G, int NSEG, bool SINK>
__device__ __forceinline__ void band_attn_naive(const Frame& F0, const bf16* P, int pitch, int segstride, int kbase, int vbase, bf16* O, int opitch, const float* sinks, int nslope) {
    Frame F = F0; F.lane = opq(lane_id()); F.tid = F0.wave * 64 + F.lane;
    constexpr int NSLOT = SINK ? 2 : 3, NKEYS = SINK ? 128 : 129;
    LAS float* qs = (LAS float*)(F.lds + RING_OFF + F.wave * 16384);
    LAS float* ps = qs + NSEG * G * 64;
    for (int item = F.gw; item < M * 4; item += F.NGW) {
        const int m = item >> 2, kvh = item & 3, t = m & (S - 1);
        asm volatile("" ::: "memory");
#pragma unroll
        for (int sg = 0; sg < NSEG; ++sg)
#pragma unroll
            for (int g = 0; g < G; ++g) qs[(sg * G + g) * 64 + F.lane] = bf2f(P[(size_t)m * pitch + sg * segstride + (kvh * G + g) * 64 + F.lane]);
        LDS_WAIT(); asm volatile("" ::: "memory");
        float lg[NSEG][NSLOT][G];
#pragma unroll
        for (int sg = 0; sg < NSEG; ++sg) {
            const int dil = sg == 0 ? 1 : (sg == 1 ? 4 : 16);
#pragma unroll
            for (int sl = 0; sl < NSLOT; ++sl) {
                asm volatile("" ::: "memory");
                const int j = sl * 64 + F.lane; const bool valid = (j < NKEYS) && (t - j * dil >= 0);
                const bf16* kr = P + (size_t)(m - (valid ? j * dil : 0)) * pitch + sg * segstride + kbase + kvh * 64;
                float kf[64];
#pragma unroll
                for (int i = 0; i < 8; ++i) { const v4u w = *(const GAS v4u*)(kr + 8 * i); unpack8(w, kf + 8 * i); }
#pragma unroll
                for (int g = 0; g < G; ++g) { float dot = 0.f;
#pragma unroll
                    for (int d4 = 0; d4 < 16; ++d4) { const f32x4 q4 = *(const LAS f32x4*)(qs + (sg * G + g) * 64 + 4 * d4); dot += kf[4 * d4] * q4.x + kf[4 * d4 + 1] * q4.y + kf[4 * d4 + 2] * q4.z + kf[4 * d4 + 3] * q4.w; }
                    const float slope = exp2f(-8.f * (float)(kvh * G + g + 1) / (float)nslope);
                    lg[sg][sl][g] = valid ? dot * 0.125f - slope * (float)(j * dil) : -INFINITY; }
            }
        }
#pragma unroll
        for (int g = 0; g < G; ++g) {
            float mx = -INFINITY;
#pragma unroll
            for (int sg = 0; sg < NSEG; ++sg)
#pragma unroll
                for (int sl = 0; sl < NSLOT; ++sl) mx = fmaxf(mx, lg[sg][sl][g]);
            mx = wave_max(mx);
            float sk = 0.f; if (SINK) { sk = sinks[kvh * G + g]; mx = fmaxf(mx, sk); }
            float sum = 0.f;
#pragma unroll
            for (int sg = 0; sg < NSEG; ++sg)
#pragma unroll
                for (int sl = 0; sl < NSLOT; ++sl) { const float e = __expf(lg[sg][sl][g] - mx); lg[sg][sl][g] = e; sum += e; }
            sum = wave_sum(sum); if (SINK) sum += __expf(sk - mx);
            const float inv = 1.0f / sum;
#pragma unroll
            for (int sg = 0; sg < NSEG; ++sg)
#pragma unroll
                for (int sl = 0; sl < NSLOT; ++sl) ps[(sg * 192 + sl * 64 + F.lane) * G + g] = lg[sg][sl][g] * inv;
        }
        LDS_WAIT(); asm volatile("" ::: "memory");
        float o[G];
#pragma unroll
        for (int g = 0; g < G; ++g) o[g] = 0.f;
#pragma unroll
        for (int sg = 0; sg < NSEG; ++sg) {
            const int dil = sg == 0 ? 1 : (sg == 1 ? 4 : 16);
            const int jmax = min(NKEYS - 1, t / dil);
            const bf16* vb = P + (size_t)m * pitch + sg * segstride + vbase + kvh * 64 + F.lane;
            for (int j0 = 0; j0 <= jmax; j0 += 8) {
                float v[8];
#pragma unroll
                for (int u = 0; u < 8; ++u) { const int jj = min(j0 + u, jmax); v[u] = bf2f(vb[-(ptrdiff_t)jj * dil * pitch]); }
#pragma unroll
                for (int u = 0; u < 8; ++u)
#pragma unroll
                    for (int g4 = 0; g4 < G; g4 += 4) { const f32x4 p4 = *(const LAS f32x4*)(ps + (sg * 192 + j0 + u) * G + g4); o[g4] += p4.x * v[u]; o[g4 + 1] += p4.y * v[u]; o[g4 + 2] += p4.z * v[u]; o[g4 + 3] += p4.w * v[u]; }
            }
        }
#pragma unroll
        for (int g = 0; g < G; ++g) O[(size_t)m * opitch + (kvh * G + g) * 64 + F.lane] = (bf16)f2bf(o[g]);
    }
}

__device__ __forceinline__ void dsa_latnorm_phase(const Frame& F0, const bf16* LAT, bf16* QL, bf16* KVL, const float* qg, const float* kvg, bf16* KI) {
    Frame F = F0; F.lane = opq(lane_id()); F.tid = F0.wave * 64 + F.lane;
    for (int m = F.gw; m < M; m += F.NGW) {
        const bf16* row = LAT + (size_t)m * DSA_INP;
        float f[8]; { const v4u w = *(const GAS v4u*)(row + 8 * F.lane); unpack8(w, f); }
        float ss = 0.f;
#pragma unroll
        for (int e = 0; e < 8; ++e) ss += f[e] * f[e];
        const float rq = 1.0f / sqrtf(wave_sum(ss) * (1.f / 512.f) + EPS);
        { const f32x4 g0 = *(const f32x4*)(qg + 8 * F.lane), g1 = *(const f32x4*)(qg + 8 * F.lane + 4);
          v4u o; o.x = pk2(f[0] * rq * g0.x, f[1] * rq * g0.y); o.y = pk2(f[2] * rq * g0.z, f[3] * rq * g0.w); o.z = pk2(f[4] * rq * g1.x, f[5] * rq * g1.y); o.w = pk2(f[6] * rq * g1.z, f[7] * rq * g1.w);
          *(GAS v4u*)(QL + (size_t)m * 512 + 8 * F.lane) = o; }
        float h[8]; float s2 = 0.f; const bool act = F.lane < 32;
        if (act) { const v4u w = *(const GAS v4u*)(row + 512 + 8 * F.lane); unpack8(w, h);
#pragma unroll
            for (int e = 0; e < 8; ++e) s2 += h[e] * h[e]; }
        s2 += __shfl_xor(s2, 1); s2 += __shfl_xor(s2, 2); s2 += __shfl_xor(s2, 4); s2 += __shfl_xor(s2, 8); s2 += __shfl_xor(s2, 16);
        if (act) { const float rk = 1.0f / sqrtf(s2 * (1.f / 256.f) + EPS); const f32x4 g0 = *(const f32x4*)(kvg + 8 * F.lane), g1 = *(const f32x4*)(kvg + 8 * F.lane + 4);
          v4u o; o.x = pk2(h[0] * rk * g0.x, h[1] * rk * g0.y); o.y = pk2(h[2] * rk * g0.z, h[3] * rk * g0.w); o.z = pk2(h[4] * rk * g1.x, h[5] * rk * g1.y); o.w = pk2(h[6] * rk * g1.z, h[7] * rk * g1.w);
          *(GAS v4u*)(KVL + (size_t)m * 256 + 8 * F.lane) = o; }
        if (F.lane < 8) { const int t = m & (S - 1), bq = m / S, d0 = 8 * F.lane; const v4u w = *(const GAS v4u*)(row + 768 + d0);
          *(GAS v4u*)(KI + ((size_t)(bq * 64 + (t >> 5)) * 4 + (d0 >> 4)) * 512 + (((d0 >> 3) & 1) * 32 + (t & 31)) * 8) = w; }
    }
}

__device__ __forceinline__ void dsa_qknorm(const Frame& F0, bf16* QQ, bf16* KV, const float* qn, const float* kn, bf16* KTd) {
    Frame F = F0; F.lane = opq(lane_id()); F.tid = F0.wave * 64 + F.lane;
    for (int m = F.gw; m < M; m += F.NGW) {
#pragma unroll
        for (int c = 0; c < 5; ++c) {
            const bool act = c < 4 || F.lane < 16;
            bf16* p = c < 4 ? QQ + (size_t)m * DSA_QQ + 512 * c + 8 * F.lane : KV + (size_t)m * 256 + 8 * F.lane;
            const float* g = (c < 4 ? qn : kn) + ((8 * F.lane) & 127);
            float f[8]; float ss = 0.f;
            if (act) { const v4u w = *(const GAS v4u*)p; unpack8(w, f);
#pragma unroll
                for (int e = 0; e < 8; ++e) ss += f[e] * f[e]; }
            ss += __shfl_xor(ss, 1); ss += __shfl_xor(ss, 2); ss += __shfl_xor(ss, 4); ss += __shfl_xor(ss, 8);
            if (act) { const float r = 1.0f / sqrtf(ss * (1.f / 128.f) + EPS); const f32x4 g0 = *(const f32x4*)g, g1 = *(const f32x4*)(g + 4);
                v4u o; o.x = pk2(f[0] * r * g0.x, f[1] * r * g0.y); o.y = pk2(f[2] * r * g0.z, f[3] * r * g0.w); o.z = pk2(f[4] * r * g1.x, f[5] * r * g1.y); o.w = pk2(f[6] * r * g1.z, f[7] * r * g1.w);
                *(GAS v4u*)p = o;
                if (c == 4) { const int t = m & (S - 1), bq = m / S, d0 = 8 * F.lane;
                    *(GAS v4u*)(KTd + ((size_t)(bq * 64 + (t >> 5)) * 8 + (d0 >> 4)) * 512 + (((d0 >> 3) & 1) * 32 + kperm5(t & 31)) * 8) = o; } }
        }
    }
}

__device__ __forceinline__ unsigned f2key(float x) { const unsigned u = __float_as_uint(x); return (u & 0x80000000u) ? ~u : (u | 0x80000000u); }
__device__ __forceinline__ void dsa_index_naive(const Frame& F0, const bf16* LAT, const bf16* QQ, unsigned short* IDX, int* NSEL) {
    Frame F = F0; F.lane = opq(lane_id()); F.tid = F0.wave * 64 + F.lane;
    LAS float* qi = (LAS float*)(F.lds + RING_OFF + F.wave * 16384);
    LAS unsigned* skey = (LAS unsigned*)(qi + 1024);
    LAS float* wl = (LAS float*)(skey + 2048);
    const unsigned long long ltmask = (1ull << F.lane) - 1ull;
    for (int m = F.gw; m < M; m += F.NGW) {
        const int t = m & (S - 1), b0 = m - t;
        if (t < 256) {
            for (int jj = F.lane; jj < 256; jj += 64) if (jj <= t) IDX[(size_t)m * 256 + jj] = (unsigned short)jj;
            if (F.lane == 0) NSEL[m] = t + 1;
            continue;
        }
        asm volatile("" ::: "memory");
#pragma unroll
        for (int r = 0; r < 2; ++r) { const int e = (r * 64 + F.lane) * 8; const v4u w = *(const GAS v4u*)(QQ + (size_t)m * DSA_QQ + 2048 + e); float f[8]; unpack8(w, f);
#pragma unroll
            for (int i = 0; i < 8; ++i) qi[e + i] = f[i]; }
        if (F.lane < 16) wl[F.lane] = bf2f(LAT[(size_t)m * DSA_INP + 832 + F.lane]) * (0.25f * 0.125f);
        LDS_WAIT(); asm volatile("" ::: "memory");
        const int nch = (t >> 6) + 1;
#pragma unroll 1
        for (int c = 0; c < nch; ++c) {
            asm volatile("" ::: "memory");
            const int s = c * 64 + F.lane; const bool valid = s <= t;
            const bf16* kr = LAT + (size_t)(b0 + (valid ? s : t)) * DSA_INP + 768;
            v4u kw[8];
#pragma unroll
            for (int i = 0; i < 8; ++i) kw[i] = *(const GAS v4u*)(kr + 8 * i);
            float kf[64];
#pragma unroll
            for (int i = 0; i < 8; ++i) unpack8(kw[i], kf + 8 * i);
            float sc = 0.f;
#pragma unroll 1
            for (int h = 0; h < 16; ++h) {
                float dot = 0.f;
#pragma unroll
                for (int d4 = 0; d4 < 16; ++d4) { const f32x4 q4 = *(const LAS f32x4*)(qi + h * 64 + 4 * d4); dot += (kf[4 * d4] * q4.x + kf[4 * d4 + 1] * q4.y) + (kf[4 * d4 + 2] * q4.z + kf[4 * d4 + 3] * q4.w); }
                sc += wl[h] * fmaxf(dot, 0.f);
            }
            skey[s] = valid ? f2key(sc) : 0u;
        }
        LDS_WAIT(); asm volatile("" ::: "memory");
        unsigned key[32];
#pragma unroll
        for (int c = 0; c < 32; ++c) key[c] = (c < nch) ? skey[c * 64 + F.lane] : 0u;
        unsigned T = 0u;
        for (int bit = 31; bit >= 0; --bit) {
            const unsigned cand = T | (1u << bit); int cnt = 0;
#pragma unroll
            for (int c = 0; c < 32; ++c) cnt += __popcll(__ballot(key[c] >= cand));
            if (cnt >= 256) T = cand;
        }
        int cgt = 0;
#pragma unroll
        for (int c = 0; c < 32; ++c) cgt += __popcll(__ballot(key[c] > T));
        const int need_eq = 256 - cgt;
        int base = 0, eqbase = 0;
#pragma unroll
        for (int c = 0; c < 32; ++c) {
            const bool gt = key[c] > T, eq = key[c] == T;
            const unsigned long long meq = __ballot(eq);
            const int eqrank = eqbase + __popcll(meq & ltmask);
            const bool sel = gt || (eq && eqrank < need_eq);
            const unsigned long long msel = __ballot(sel);
            const int pos = base + __popcll(msel & ltmask);
            if (sel && pos < 256) IDX[(size_t)m * 256 + pos] = (unsigned short)(c * 64 + F.lane);
            base += __popcll(msel); eqbase += __popcll(meq);
        }
        if (F.lane == 0) NSEL[m] = base < 256 ? base : 256;
    }
}

__device__ __forceinline__ void dsa_attn_naive(const Frame& F0, const bf16* QQ, const bf16* KV, const unsigned short* IDX, const int* NSEL, bf16* O) {
    Frame F = F0; F.lane = opq(lane_id()); F.tid = F0.wave * 64 + F.lane;
    LAS float* qs = (LAS float*)(F.lds + RING_OFF + F.wave * 16384);
    LAS float* ps = qs + 2048;
    for (int m = F.gw; m < M; m += F.NGW) {
        const int t = m & (S - 1), b0 = m - t; const int n = NSEL[m];
        asm volatile("" ::: "memory");
#pragma unroll
        for (int r = 0; r < 4; ++r) { const int e = (r * 64 + F.lane) * 8; const v4u w = *(const GAS v4u*)(QQ + (size_t)m * DSA_QQ + e); float f[8]; unpack8(w, f);
            *(LAS f32x4*)(qs + e) = (f32x4){f[0], f[1], f[2], f[3]}; *(LAS f32x4*)(qs + e + 4) = (f32x4){f[4], f[5], f[6], f[7]}; }
        LDS_WAIT(); asm volatile("" ::: "memory");
        int sidx[4];
#pragma unroll
        for (int sl = 0; sl < 4; ++sl) { const int jj = sl * 64 + F.lane; sidx[sl] = (jj < n) ? (int)IDX[(size_t)m * 256 + jj] : 0; }
#pragma unroll 1
        for (int hh = 0; hh < 2; ++hh) {
#pragma unroll 1
            for (int sl = 0; sl < 4; ++sl) {
                const int jj = sl * 64 + F.lane; const bool val = jj < n; const int sx = val ? (int)IDX[(size_t)m * 256 + jj] : 0;
                const bf16* kr = KV + (size_t)(b0 + sx) * 256;
                float kf[128];
#pragma unroll
                for (int i = 0; i < 16; ++i) { const v4u w = *(const GAS v4u*)(kr + 8 * i); unpack8(w, kf + 8 * i); }
#pragma unroll 1
                for (int h = 0; h < 8; ++h) {
                    const LAS float* qh = qs + (hh * 8 + h) * 128; float dot = 0.f;
#pragma unroll
                    for (int d4 = 0; d4 < 32; ++d4) { const f32x4 q4 = *(const LAS f32x4*)(qh + 4 * d4); dot += (kf[4 * d4] * q4.x + kf[4 * d4 + 1] * q4.y) + (kf[4 * d4 + 2] * q4.z + kf[4 * d4 + 3] * q4.w); }
                    const float slope = exp2f(-0.5f * (float)(hh * 8 + h + 1));
                    ps[jj * 8 + h] = val ? dot * 0.08838834764831845f - slope * (float)(t - sx) : -INFINITY;
                }
            }
            LDS_WAIT(); asm volatile("" ::: "memory");
            float inv_sum[8];
#pragma unroll
            for (int h = 0; h < 8; ++h) {
                float l0 = ps[(F.lane) * 8 + h], l1 = ps[(64 + F.lane) * 8 + h], l2 = ps[(128 + F.lane) * 8 + h], l3 = ps[(192 + F.lane) * 8 + h];
                const float mx = wave_max(fmaxf(fmaxf(l0, l1), fmaxf(l2, l3)));
                l0 = __expf(l0 - mx); l1 = __expf(l1 - mx); l2 = __expf(l2 - mx); l3 = __expf(l3 - mx);
                inv_sum[h] = 1.0f / wave_sum((l0 + l1) + (l2 + l3));
                ps[(F.lane) * 8 + h] = l0; ps[(64 + F.lane) * 8 + h] = l1; ps[(128 + F.lane) * 8 + h] = l2; ps[(192 + F.lane) * 8 + h] = l3;
            }
            LDS_WAIT(); asm volatile("" ::: "memory");
            float o[8][2];
#pragma unroll
            for (int h = 0; h < 8; ++h) { o[h][0] = 0.f; o[h][1] = 0.f; }
#pragma unroll
            for (int sl = 0; sl < 4; ++sl) {
                if (sl * 64 < n) {
#pragma unroll 1
                    for (int j0 = 0; j0 < 64; j0 += 4) {
                        unsigned vw[4];
#pragma unroll
                        for (int u = 0; u < 4; ++u) { const int sx = __builtin_amdgcn_readlane(sidx[sl], j0 + u); vw[u] = *(const GAS unsigned*)(KV + (size_t)(b0 + sx) * 256 + 128 + 2 * F.lane); }
#pragma unroll
                        for (int u = 0; u < 4; ++u) {
                            const float v0 = bflo(vw[u]), v1 = bfhi(vw[u]); const int jj = sl * 64 + j0 + u;
                            const f32x4 p0 = *(const LAS f32x4*)(ps + jj * 8), p1 = *(const LAS f32x4*)(ps + jj * 8 + 4);
                            o[0][0] += p0.x * v0; o[0][1] += p0.x * v1; o[1][0] += p0.y * v0; o[1][1] += p0.y * v1; o[2][0] += p0.z * v0; o[2][1] += p0.z * v1; o[3][0] += p0.w * v0; o[3][1] += p0.w * v1;
                            o[4][0] += p1.x * v0; o[4][1] += p1.x * v1; o[5][0] += p1.y * v0; o[5][1] += p1.y * v1; o[6][0] += p1.z * v0; o[6][1] += p1.z * v1; o[7][0] += p1.w * v0; o[7][1] += p1.w * v1;
                        }
                    }
                }
            }
#pragma unroll
            for (int h = 0; h < 8; ++h) *(GAS unsigned*)(O + (size_t)m * D + (hh * 8 + h) * 128 + 2 * F.lane) = pk2(o[h][0] * inv_sum[h], o[h][1] * inv_sum[h]);
            LDS_WAIT(); asm volatile("" ::: "memory");
        }
    }
}
typedef short bf16x8v __attribute__((ext_vector_type(8)));
typedef float f32x16v __attribute__((ext_vector_type(16)));
__device__ __forceinline__ bf16x8v ld_frag(const bf16* p) { return __builtin_bit_cast(bf16x8v, *(const GAS v4u*)p); }
__device__ __forceinline__ bf16x8v pack_frag(float a0, float a1, float a2, float a3, float a4, float a5, float a6, float a7) {
    v4u w; w.x = pg8::cvt_pk_bf16(a0, a1); w.y = pg8::cvt_pk_bf16(a2, a3); w.z = pg8::cvt_pk_bf16(a4, a5); w.w = pg8::cvt_pk_bf16(a6, a7); return __builtin_bit_cast(bf16x8v, w); }
template <int G, bool SINK, bool KTI = true, bool VTI = true>
__device__ __forceinline__ void band_attn_mfma(const Frame& F0, const bf16* P, int pitch, int qcol0, const bf16* KT, const bf16* VT, int dshift, bf16* Ob, int opitch, int ocol0, float* LSE, const float* sinks, int nheads_total, int kcol0 = 0, bool vtiled = true) {
    Frame F = F0; F.lane = opq(lane_id()); F.tid = F0.wave * 64 + F.lane;
    constexpr int QPI = 32 / G, WMAX = SINK ? 127 : 128;
    const int Ssub = S >> dshift, per = Ssub / QPI, nitems = BATCH * 4 * (S / QPI);
    const int l31 = F.lane & 31, hh = F.lane >> 5;
    const int kperm = (l31 & ~12) | ((l31 & 4) << 1) | ((l31 & 8) >> 1);
    const int qi = l31 / G, hd = l31 % G;
    for (int item = F.gw; item < nitems; item += F.NGW) {
        const int qg = item % per, rest = item / per, r = rest & ((1 << dshift) - 1), rest2 = rest >> dshift, kvh = rest2 & 3, b = rest2 >> 2;
        const int u0 = qg * QPI, kt0 = (u0 >> 5) - 4, kstart = 32 * kt0;
        const size_t tbase = ((size_t)(b * 4 + kvh)) * (64 * S) + (size_t)r * (Ssub * 64);
        const int u = u0 + qi, head = kvh * G + hd;
        const size_t m = (size_t)b * S + ((size_t)u << dshift) + r;
        const float slope = exp2f(-8.f * (float)(head + 1) / (float)nheads_total) * (float)(1 << dshift);
        bf16x8v qf[4];
#pragma unroll
        for (int ks = 0; ks < 4; ++ks) qf[ks] = ld_frag(P + m * pitch + qcol0 + head * 64 + 16 * ks + 8 * hh);
        bf16x8v kf[5][4];
#pragma unroll
        for (int T = 0; T < 5; ++T) {
            const int kt = (kt0 + T) < 0 ? 0 : (kt0 + T);
            if (KTI) { const bf16* kr = KT + tbase + (size_t)kt * 2048;
#pragma unroll
                for (int ks = 0; ks < 4; ++ks) kf[T][ks] = ld_frag(kr + ks * 512 + F.lane * 8); }
            else { int sl = 32 * kt + kperm; sl = sl > Ssub - 1 ? Ssub - 1 : sl;
                const bf16* kr = P + ((size_t)b * S + ((size_t)sl << dshift) + r) * pitch + kcol0 + kvh * 64 + 8 * hh;
#pragma unroll
                for (int ks = 0; ks < 4; ++ks) kf[T][ks] = ld_frag(kr + 16 * ks); }
        }
        f32x16v sT[5];
#pragma unroll
        for (int T = 0; T < 5; ++T) {
            const int tb = kstart + 32 * T;
            f32x16v acc;
#pragma unroll
            for (int e = 0; e < 16; ++e) acc[e] = 0.f;
#pragma unroll
            for (int ks = 0; ks < 4; ++ks) acc = __builtin_amdgcn_mfma_f32_32x32x16_bf16(kf[T][ks], qf[ks], acc, 0, 0, 0);
#pragma unroll
            for (int e = 0; e < 16; ++e) { const int ko = 16 * (e >> 3) + 8 * hh + 4 * ((e >> 2) & 1) + (e & 3); const int s = tb + ko, dist = u - s;
                const bool valid = (dist >= 0) && (dist <= WMAX) && (s >= 0);
                acc[e] = valid ? acc[e] * 0.125f - slope * (float)dist : -INFINITY; }
            sT[T] = acc;
        }
        bf16x8v vf[5][2][2];
#pragma unroll
        for (int T = 0; T < 5; ++T) {
            const int kt = (kt0 + T) < 0 ? 0 : (kt0 + T);
            if (VTI && vtiled) { const bf16* vr = VT + tbase + (size_t)kt * 2048;
#pragma unroll
                for (int s2 = 0; s2 < 2; ++s2)
#pragma unroll
                    for (int c = 0; c < 2; ++c) vf[T][s2][c] = ld_frag(vr + c * 1024 + 16 * s2 + l31 * 32 + 8 * hh); }
            else { const bf16* vbase = VT + ((size_t)(b * 4 + kvh) * 64 + l31) * S + (size_t)r * Ssub;
#pragma unroll
                for (int s2 = 0; s2 < 2; ++s2)
#pragma unroll
                    for (int c = 0; c < 2; ++c) vf[T][s2][c] = ld_frag(vbase + (size_t)(32 * c) * S + 32 * kt + 16 * s2 + 8 * hh); }
        }
        float mx = -INFINITY;
#pragma unroll
        for (int T = 0; T < 5; ++T)
#pragma unroll
            for (int e = 0; e < 16; ++e) mx = fmaxf(mx, sT[T][e]);
        mx = fmaxf(mx, __shfl_xor(mx, 32));
        float sk = 0.f; if (SINK) { sk = sinks[head]; mx = fmaxf(mx, sk); }
        float sum = 0.f;
#pragma unroll
        for (int T = 0; T < 5; ++T)
#pragma unroll
            for (int e = 0; e < 16; ++e) { const float p = __expf(sT[T][e] - mx); sT[T][e] = p; sum += p; }
        sum += __shfl_xor(sum, 32);
        if (SINK) sum += __expf(sk - mx);
        f32x16v oT[2];
#pragma unroll
        for (int c = 0; c < 2; ++c)
#pragma unroll
            for (int e = 0; e < 16; ++e) oT[c][e] = 0.f;
#pragma unroll
        for (int T = 0; T < 5; ++T)
#pragma unroll
            for (int s2 = 0; s2 < 2; ++s2) {
                const bf16x8v pb = pack_frag(sT[T][8 * s2], sT[T][8 * s2 + 1], sT[T][8 * s2 + 2], sT[T][8 * s2 + 3], sT[T][8 * s2 + 4], sT[T][8 * s2 + 5], sT[T][8 * s2 + 6], sT[T][8 * s2 + 7]);
#pragma unroll
                for (int c = 0; c < 2; ++c) oT[c] = __builtin_amdgcn_mfma_f32_32x32x16_bf16(vf[T][s2][c], pb, oT[c], 0, 0, 0);
            }
        const float inv = 1.0f / sum;
        bf16* orow = Ob + m * opitch + ocol0 + head * 64 + 4 * hh;
#pragma unroll
        for (int c = 0; c < 2; ++c)
#pragma unroll
            for (int r4 = 0; r4 < 4; ++r4) { v2u w; w.x = pg8::cvt_pk_bf16(oT[c][4 * r4] * inv, oT[c][4 * r4 + 1] * inv); w.y = pg8::cvt_pk_bf16(oT[c][4 * r4 + 2] * inv, oT[c][4 * r4 + 3] * inv);
                *(GAS v2u*)(orow + 32 * c + 8 * r4) = w; }
        if (!SINK) { if (hh == 0) LSE[m * 16 + head] = mx + __logf(sum); }
    }
}
__device__ __forceinline__ void dil_combine(const Frame& F0, const bf16* P, const float* LSE, bf16* O) {
    Frame F = F0; F.lane = opq(lane_id()); F.tid = F0.wave * 64 + F.lane;
    for (int m = F.gw; m < M; m += F.NGW) {
#pragma unroll
        for (int i = 0; i < 2; ++i) {
            const int col = 8 * F.lane + 512 * i, head = col >> 6;
            const float l0 = LSE[(size_t)m * 16 + head], l1 = LSE[(size_t)(M + m) * 16 + head], l2 = LSE[(size_t)(2 * M + m) * 16 + head];
            const float mx = fmaxf(l0, fmaxf(l1, l2)); float w0 = __expf(l0 - mx), w1 = __expf(l1 - mx), w2 = __expf(l2 - mx); const float inv = 1.0f / (w0 + w1 + w2); w0 *= inv; w1 *= inv; w2 *= inv;
            float a[8], bq[8], c[8];
            unpack8(*(const GAS v4u*)(P + (size_t)m * DIL_IN + col), a); unpack8(*(const GAS v4u*)(P + (size_t)m * DIL_IN + 1536 + col), bq); unpack8(*(const GAS v4u*)(P + (size_t)m * DIL_IN + 3072 + col), c);
            v4u o; o.x = pk2(w0 * a[0] + w1 * bq[0] + w2 * c[0], w0 * a[1] + w1 * bq[1] + w2 * c[1]); o.y = pk2(w0 * a[2] + w1 * bq[2] + w2 * c[2], w0 * a[3] + w1 * bq[3] + w2 * c[3]);
            o.z = pk2(w0 * a[4] + w1 * bq[4] + w2 * c[4], w0 * a[5] + w1 * bq[5] + w2 * c[5]); o.w = pk2(w0 * a[6] + w1 * bq[6] + w2 * c[6], w0 * a[7] + w1 * bq[7] + w2 * c[7]);
            *(GAS v4u*)(O + (size_t)m * 1024 + col) = o;
        }
    }
}
__device__ __forceinline__ void dsa_fused(const Frame& F0, const bf16* LAT, const bf16* QQ, const bf16* KTd, const bf16* KI, const bf16* VT, bf16* O, const bf16* KVraw) {
    Frame F = F0; F.lane = opq(lane_id()); F.tid = F0.wave * 64 + F.lane;
    LAS unsigned* sk = (LAS unsigned*)(F.lds + RING_OFF + F.wave * 16384);
    const int l31 = F.lane & 31, hh = F.lane >> 5;
    const int kperm = (l31 & ~12) | ((l31 & 4) << 1) | ((l31 & 8) >> 1);
    constexpr int NITEM = M / 2, PER_B = S / 2;
    int pass = 0;
    for (int item = F.gw; item < NITEM; item += F.NGW, ++pass) {
        const int b = item / PER_B; int tp = item % PER_B; if (pass & 1) tp = PER_B - 1 - tp;
        const int t0 = 2 * tp; const size_t b0 = (size_t)b * S, m0 = b0 + t0;
        const int ntile = ((t0 + 1) >> 5) + 1;
        asm volatile("" ::: "memory");
        {
            bf16x8v af[4];
            { const int qsel = (l31 >> 2) & 1, head = (l31 >> 3) * 4 + (l31 & 3);
#pragma unroll
              for (int ks = 0; ks < 4; ++ks) af[ks] = ld_frag(QQ + (m0 + qsel) * DSA_QQ + 2048 + head * 64 + 16 * ks + 8 * hh); }
            float wv[16];
            { float f[8]; unpack8(*(const GAS v4u*)(LAT + (m0 + hh) * DSA_INP + 832), f);
#pragma unroll
              for (int e = 0; e < 8; ++e) wv[e] = f[e] * (0.25f * 0.125f);
              unpack8(*(const GAS v4u*)(LAT + (m0 + hh) * DSA_INP + 840), f);
#pragma unroll
              for (int e = 0; e < 8; ++e) wv[8 + e] = f[e] * (0.25f * 0.125f); }
            const int tq = t0 + hh;
#define DSA_LDK(dst, T_) do { const bf16* kr_ = KI + ((size_t)b * 64 + (T_)) * 2048;   _Pragma("unroll") for (int ks = 0; ks < 4; ++ks) dst[ks] = ld_frag(kr_ + ks * 512 + F.lane * 8); } while (0)
#define DSA_SCORE(src, T_) do { f32x16v acc; _Pragma("unroll") for (int e = 0; e < 16; ++e) acc[e] = 0.f; \
                _Pragma("unroll") for (int ks = 0; ks < 4; ++ks) acc = __builtin_amdgcn_mfma_f32_32x32x16_bf16(af[ks], src[ks], acc, 0, 0, 0); \
                float sc = 0.f; _Pragma("unroll") for (int e = 0; e < 16; ++e) sc = __builtin_fmaf(wv[e], fmaxf(acc[e], 0.f), sc); \
                const int s_ = 32 * (T_) + l31; sk[hh * 2048 + s_] = (s_ <= tq) ? f2key(sc) : 0u; } while (0)
            bf16x8v kA[4], kB[4];
            DSA_LDK(kA, 0);
            for (int T = 0;;) {
                if (T + 1 < ntile) DSA_LDK(kB, T + 1);
                DSA_SCORE(kA, T);
                if (++T >= ntile) break;
                if (T + 1 < ntile) DSA_LDK(kA, T + 1);
                DSA_SCORE(kB, T);
                if (++T >= ntile) break;
            }
#undef DSA_LDK
#undef DSA_SCORE
        }
        LDS_WAIT(); asm volatile("" ::: "memory");
        unsigned Tsel[2];
#pragma unroll
        for (int q = 0; q < 2; ++q) {
            const int tq = t0 + q;
            unsigned T = 1u;
            if (tq >= 256) {
                const int nch = (tq >> 6) + 1;
                unsigned key[32];
#pragma unroll
                for (int c = 0; c < 32; ++c) key[c] = (c < nch && c * 64 + F.lane <= tq) ? sk[q * 2048 + c * 64 + F.lane] : 0u;
                T = 0u;
#pragma unroll 1
                for (int bit = 31; bit >= 0; --bit) {
                    const unsigned cand = T | (1u << bit); int cnt = 0;
#pragma unroll
                    for (int c = 0; c < 32; ++c) cnt += __popcll(__ballot(key[c] >= cand));
                    if (cnt >= 256) T = cand;
                }
            }
            Tsel[q] = T;
        }
        const int qsel = l31 >> 4, head = l31 & 15, tq = t0 + qsel;
        const unsigned Tm = qsel ? Tsel[1] : Tsel[0];
        const float slope = exp2f(-0.5f * (float)(head + 1));
        bf16x8v qf[8];
#pragma unroll
        for (int ks = 0; ks < 8; ++ks) qf[ks] = ld_frag(QQ + (m0 + qsel) * DSA_QQ + head * 128 + 16 * ks + 8 * hh);
        f32x16v oT[4];
#pragma unroll
        for (int c = 0; c < 4; ++c)
#pragma unroll
            for (int e = 0; e < 16; ++e) oT[c][e] = 0.f;
        float mrun = -INFINITY, lrun = 0.f;
        const unsigned voff = (unsigned)(l31 * 32 + 8 * hh);
#define DSA_LDK2(kd, T_) do { const bf16* kr_ = KTd + ((size_t)b * 64 + (T_)) * 4096;   _Pragma("unroll") for (int ks = 0; ks < 8; ++ks) kd[ks] = ld_frag(kr_ + ks * 512 + F.lane * 8); } while (0)
#define DSA_LDVH(vd, T_, s2_) do { const bf16* vu_ = VT + ((size_t)b * 64 + (T_)) * 4096;   _Pragma("unroll") for (int c = 0; c < 4; ++c) vd[c] = ld_frag(vu_ + c * 1024 + 16 * (s2_) + voff); } while (0)
        {
            bf16x8v kf[8], v0[4], v1[4];
            DSA_LDK2(kf, 0);
#pragma unroll 1
            for (int T = 0; T < ntile; ++T) {
                const int tb = 32 * T;
                DSA_LDVH(v0, T, 0); DSA_LDVH(v1, T, 1);
                f32x16v acc;
#pragma unroll
                for (int e = 0; e < 16; ++e) acc[e] = 0.f;
#pragma unroll
                for (int ks = 0; ks < 8; ++ks) acc = __builtin_amdgcn_mfma_f32_32x32x16_bf16(kf[ks], qf[ks], acc, 0, 0, 0);
                if (T + 1 < ntile) DSA_LDK2(kf, T + 1);
                asm volatile("" ::: "memory");
                float tmax = -INFINITY;
#pragma unroll
                for (int e4 = 0; e4 < 4; ++e4) { if (e4 == 2) asm volatile("" ::: "memory"); const int ko4 = 16 * (e4 >> 1) + 8 * hh + 4 * (e4 & 1); const v4u k4 = *(const LAS v4u*)(sk + qsel * 2048 + tb + ko4);
#pragma unroll
                    for (int i = 0; i < 4; ++i) { const int e = 4 * e4 + i; const int s_ = tb + ko4 + i; const unsigned kk = i == 0 ? k4.x : (i == 1 ? k4.y : (i == 2 ? k4.z : k4.w));
                        const float lg = (kk >= Tm) ? acc[e] * 0.08838834764831845f - slope * (float)(tq - s_) : -INFINITY; acc[e] = lg; tmax = fmaxf(tmax, lg); } }
                tmax = fmaxf(tmax, __shfl_xor(tmax, 32));
                const float mnew = fmaxf(mrun, tmax), msub = (mnew == -INFINITY) ? 0.f : mnew; const float alpha = __expf(mrun - msub); mrun = mnew;
                float ps = 0.f;
#pragma unroll
                for (int e = 0; e < 16; ++e) { const float p = __expf(acc[e] - msub); acc[e] = p; ps += p; }
                lrun = lrun * alpha + ps;
#pragma unroll
                for (int c = 0; c < 4; ++c)
#pragma unroll
                    for (int e = 0; e < 16; ++e) oT[c][e] *= alpha;
                asm volatile("" ::: "memory");
#pragma unroll
                for (int s2 = 0; s2 < 2; ++s2) {
                    const bf16x8v pb = pack_frag(acc[8 * s2], acc[8 * s2 + 1], acc[8 * s2 + 2], acc[8 * s2 + 3], acc[8 * s2 + 4], acc[8 * s2 + 5], acc[8 * s2 + 6], acc[8 * s2 + 7]);
#pragma unroll
                    for (int c = 0; c < 4; ++c) oT[c] = __builtin_amdgcn_mfma_f32_32x32x16_bf16(s2 == 0 ? v0[c] : v1[c], pb, oT[c], 0, 0, 0); }
            }
        }
#undef DSA_LDK2
#undef DSA_LDVH
#undef DSA_TILE
        lrun += __shfl_xor(lrun, 32);
        const float inv = 1.0f / lrun;
        const int lz = opq(lane_id());
        bf16* orow = O + (m0 + ((lz & 31) >> 4)) * D + (lz & 15) * 128 + 4 * (lz >> 5);
#pragma unroll
        for (int c = 0; c < 4; ++c)
#pragma unroll
            for (int r4 = 0; r4 < 4; ++r4) { v2u w; w.x = pg8::cvt_pk_bf16(oT[c][4 * r4] * inv, oT[c][4 * r4 + 1] * inv); w.y = pg8::cvt_pk_bf16(oT[c][4 * r4 + 2] * inv, oT[c][4 * r4 + 3] * inv);
                *(GAS v2u*)(orow + 32 * c + 8 * r4) = w; }
        LDS_WAIT(); asm volatile("" ::: "memory");
    }
}
#define GRID_BAR() xcd_barrier(bar)
struct Args { const float* in[26]; float* out; unsigned char* ws; };
template <int L>
__device__ __forceinline__ void layer_fwd(Frame& F, const Args& args, const XcdBarrier& bar) {
    unsigned char* ws = args.ws;
    const float* x_in = args.in[0];
    float* out = args.out;
    float* MOD = (float*)(ws + WS_MOD);
    bf16* H = (bf16*)(ws + WS_H);
    bf16* PROJ = (bf16*)(ws + WS_PROJ);
    bf16* OB = (bf16*)(ws + WS_O);
    bf16* KT = (bf16*)(ws + WS_KT); bf16* KI = (bf16*)(ws + WS_KI);
    bf16* VT = (bf16*)(ws + WS_VT); float* LSE = (float*)(ws + WS_LSE); bf16* VTD = (bf16*)(ws + WS_VTD);
    bf16* HID = (bf16*)(ws + WS_BIG);
    bf16* LAT = (bf16*)(ws + WS_LAT); bf16* QL = (bf16*)(ws + WS_QL); bf16* KVL = (bf16*)(ws + WS_KVL); bf16* KV = (bf16*)(ws + WS_KV);
    bf16* QQ = (bf16*)(ws + WS_QQ);
    {
        constexpr int l = L, kind = L % 3, j = L / 3;
        const float* modl = MOD + (size_t)l * 8 * 12288;
        bf16* XB = (bf16*)(ws + WS_XB);
        if constexpr (l == 0) norm_phase<false>(F, x_in, args.in[4] + l * D, modl, 0, 2048, H); else norm_phase<true>(F, XB, args.in[4] + l * D, modl, 0, 2048, H);
#if PROBE == 4
        if constexpr (l == 0) norm_phase<false>(F, x_in, args.in[4] + l * D, modl, 0, 2048, H); else norm_phase<true>(F, XB, args.in[4] + l * D, modl, 0, 2048, H);
#endif
        GRID_BAR();
        {
            const bf16* Wt = kind == 0 ? (const bf16*)(ws + WS_SWA_IN_T) + (size_t)j * SWA_IN * D : (kind == 1 ? (const bf16*)(ws + WS_DSA_IN_T) : (const bf16*)(ws + WS_DIL_IN_T));
            const int Nin = kind == 0 ? SWA_IN : (kind == 1 ? DSA_INP : DIL_IN);
            pg8::Gemm g{H, Wt, M, Nin, D}; pg8::StaticOrder So; So.init(M, Nin, F.G, (int)blockIdx.x);
            pg8::EpiQKV E{PROJ, Nin, VT, KT, kind == 0 ? 16 : (kind == 1 ? 1 : 6), kind == 0 ? 9 : 5, kind == 0 ? 8 : 4, kind == 0 ? 8 : 4, S, kind == 0 ? args.in[9] + j * 64 : args.in[23], kind == 0 ? args.in[10] + j * 64 : args.in[24], (LAS float*)(F.lds + XCH_OFF), kind == 1 ? 0 : 1};
            pg8::gemm_phase<pg8::EpiQKV, pg8::StaticOrder, true, true>(F.lds + RING_OFF, g, So, E, F.wave);
        }
        GRID_BAR();
        if constexpr (kind == 0) {
            band_attn_mfma<8, true>(F, PROJ, SWA_IN, 0, KT, VT, 0, OB, D, 0, nullptr, args.in[11] + j * 32, 32);
#if PROBE == 3
            band_attn_mfma<8, true>(F, PROJ, SWA_IN, 0, KT, VT, 0, OB, D, 0, nullptr, args.in[11] + j * 32, 32);
#endif
        } else if constexpr (kind == 1) {
            dsa_latnorm_phase(F, LAT, QL, KVL, args.in[14], args.in[15], KI);
            GRID_BAR();
            {
                pg8::Gemm g{QL, (const bf16*)(ws + WS_DSA_UQ_T), M, DSA_QQ, 512}; pg8::StaticOrder So; So.init(M, DSA_QQ, F.G, (int)blockIdx.x);
                pg8::EpiQd E{QQ, DSA_QQ, args.in[19], (LAS float*)(F.lds + XCH_OFF)};
                pg8::gemm_phase<pg8::EpiQd, pg8::StaticOrder, true, true>(F.lds + RING_OFF, g, So, E, F.wave);
            }
            __syncthreads();
            {
                pg8::Gemm g{KVL, (const bf16*)(ws + WS_DSA_UKV_T), M, 256, 256}; pg8::StaticOrder So; So.init(M, 256, F.G, (int)blockIdx.x);
                pg8::EpiKVd E{KT, VTD, S, args.in[20], (LAS float*)(F.lds + XCH_OFF)};
                pg8::gemm_phase<pg8::EpiKVd, pg8::StaticOrder, true, true>(F.lds + RING_OFF, g, So, E, F.wave);
            }
            GRID_BAR();
            dsa_fused(F, LAT, QQ, KT, KI, VTD, OB, KV);
#if PROBE == 2
            dsa_fused(F, LAT, QQ, KT, KI, VTD, OB, KV);
#endif
        } else {
#pragma unroll 1
            for (int gi = 0; gi < 3; ++gi)
                band_attn_mfma<4, false>(F, PROJ, DIL_IN, gi * 1536, KT + (size_t)gi * 8 * 4 * 64 * S, VT + (size_t)gi * 8 * 4 * 64 * S, 2 * gi, PROJ, DIL_IN, gi * 1536, LSE + (size_t)gi * M * 16, nullptr, 16, gi * 1536 + 1024, ((VT_TILED_MASK >> gi) & 1) != 0);
            GRID_BAR();
            dil_combine(F, PROJ, LSE, OB);
        }
        GRID_BAR();
        {
            const bf16* Wt = kind == 0 ? (const bf16*)(ws + WS_SWA_OUT_T) + (size_t)j * D * D : (kind == 1 ? (const bf16*)(ws + WS_DSA_OUT_T) : (const bf16*)(ws + WS_DIL_OUT_T));
            const int Ko = kind == 2 ? 1024 : D;
            pg8::Gemm g{OB, Wt, M, D, Ko}; pg8::StaticOrder So; So.init(M, D, F.G, (int)blockIdx.x);
            pg8::EpiResGate<l != 0, true> E{l == 0 ? (const void*)x_in : (const void*)XB, XB, D, modl + 4096, 12288, S};
            pg8::gemm_phase<pg8::EpiResGate<l != 0, true>, pg8::StaticOrder, true, true>(F.lds + RING_OFF, g, So, E, F.wave);
        }
        GRID_BAR();
        norm_phase<true>(F, XB, args.in[5] + l * D, modl, 6144, 8192, H);
#if PROBE == 4
        norm_phase<true>(F, XB, args.in[5] + l * D, modl, 6144, 8192, H);
#endif
        GRID_BAR();
        {
            pg8::Gemm g{H, (const bf16*)(ws + WS_W1T) + (size_t)l * FF * D, M, FF, D}; pg8::StaticOrder So; So.init(M, FF, F.G, (int)blockIdx.x);
            pg8::EpiBf16S<1> E{HID, FF};
            pg8::gemm_phase<pg8::EpiBf16S<1>, pg8::StaticOrder, true, true>(F.lds + RING_OFF, g, So, E, F.wave);
#if PROBE == 5
            __syncthreads();
            pg8::gemm_phase<pg8::EpiBf16S<1>, pg8::StaticOrder, true, true>(F.lds + RING_OFF, g, So, E, F.wave);
#endif
        }
        GRID_BAR();
        {
            pg8::Gemm g{HID, (const bf16*)(ws + WS_W2T) + (size_t)l * D * FF, M, D, FF}; pg8::StaticOrder So; So.init(M, D, F.G, (int)blockIdx.x);
            pg8::EpiResGate<true, l != DEPTH - 1> E{XB, l == DEPTH - 1 ? (void*)out : (void*)XB, D, modl + 10240, 12288, S};
            pg8::gemm_phase<pg8::EpiResGate<true, l != DEPTH - 1>, pg8::StaticOrder, true, true>(F.lds + RING_OFF, g, So, E, F.wave);
        }
        GRID_BAR();
        }
}
__global__ void __launch_bounds__(NT, 2) fwd_kernel(Args args) {
    extern __shared__ __attribute__((aligned(16))) unsigned char lds[];
    Frame F;
    F.lds = (LAS unsigned char*)lds;
    F.wave = __builtin_amdgcn_readfirstlane((int)threadIdx.x >> 6); F.lane = lane_id(); F.tid = F.wave * 64 + F.lane;
    F.G = gridDim.x; F.gw = blockIdx.x * NWAVES + F.wave; F.NGW = F.G * NWAVES;
    unsigned char* ws = args.ws;
    unsigned* ctl = (unsigned*)(ws + WS_CTL);
    for (int u = F.tid; u < (LDS_BYTES - LDSCTL_OFF) / 4; u += NT) ((LAS unsigned*)(F.lds + LDSCTL_OFF))[u] = 0u;
    __syncthreads();
    XcdBarrier bar = xcd_barrier_post(ctl + CW_BAR, (volatile LAS unsigned*)(F.lds + MISC_OFF) + 8, F.wave);

    float* MOD = (float*)(ws + WS_MOD);

    p0_ada(F, args.in[1], args.in[2], args.in[3], MOD);
    __syncthreads();
    p0_weights(F, args.in, ws);
#if PROBE == 1
    __syncthreads(); p0_ada(F, args.in[1], args.in[2], args.in[3], MOD);
    __syncthreads();
    p0_weights(F, args.in, ws);
#endif
    GRID_BAR();

    layer_fwd<0>(F, args, bar);
    layer_fwd<1>(F, args, bar);
    layer_fwd<2>(F, args, bar);
    layer_fwd<3>(F, args, bar);
}

extern "C" void kernel_launch(void* const* d_in, const int* in_sizes, int n_in, void* d_out, int out_size, void* d_ws, size_t ws_size, hipStream_t stream) {
    static int grid = 0;
    if (grid == 0) {
        if (n_in != 26 || in_sizes[0] != M * D || out_size != M * D || ws_size < WS_END) { fprintf(stderr, "kernel_launch: unexpected shapes / workspace (n_in %d, ws %zu)\n", n_in, ws_size); grid = -1; return; }
        int dev = 0, cus = 0, per_cu = 0;
        if (hipGetDevice(&dev) != hipSuccess || hipDeviceGetAttribute(&cus, hipDeviceAttributeMultiprocessorCount, dev) != hipSuccess) { grid = -1; return; }
        if (hipFuncSetAttribute((const void*)fwd_kernel, hipFuncAttributeMaxDynamicSharedMemorySize, LDS_BYTES) != hipSuccess) { grid = -1; return; }
        if (hipOccupancyMaxActiveBlocksPerMultiprocessor(&per_cu, (const void*)fwd_kernel, NT, LDS_BYTES) != hipSuccess || per_cu < 1) { fprintf(stderr, "kernel_launch: occupancy query reports %d\n", per_cu); }
        (void)hipGetLastError();
        grid = cus;
    }
    if (grid < 0) return;
    if (hipMemsetAsync((char*)d_ws + WS_CTL, 0, CTL_ZERO_BYTES, stream) != hipSuccess) return;
    Args a{};
    for (int i = 0; i < 26; ++i) a.in[i] = (const float*)d_in[i];
    a.out = (float*)d_out; a.ws = (unsigned char*)d_ws;
    hipLaunchKernelGGL(fwd_kernel, dim3(grid), dim3(NT), LDS_BYTES, stream, a);
}
```
